# Optimizing an MI355X kernel written in HIP

```python
import jax, jax.numpy as jnp
from jax import lax
import numpy as np

D_MODEL = 1024
BATCH = 8
SEQ = 2048
DEPTH = 1

N_META = 16
EPS = 1e-6
MLA_HEADS = 8
MLA_NOPE = 64
MLA_ROPE = 32
MLA_V = 64
Q_LORA = 384
KV_LORA = 256
ROPE_BASE = 10000.0
Q_BLOCK = 128
MLA_WIDTH = MLA_HEADS * MLA_V
HG_HEADS = 4
HG_DK = 128
HG_DV = 128
HG_CHUNK = 64
HG_FWIDTH = HG_HEADS * HG_DK
HG_WIDTH = HG_HEADS * HG_DV
N_GROUPS = 8
EXPERTS_PER_GROUP = 8
N_EXPERTS = N_GROUPS * EXPERTS_PER_GROUP
TOP_K = 2
D_EXPERT = 256
MOE_BLOCK = 128
IN_SIZES = (Q_LORA, KV_LORA, MLA_ROPE, HG_FWIDTH, HG_FWIDTH, HG_WIDTH, HG_WIDTH, D_MODEL, D_MODEL)
D_IN = sum(IN_SIZES)

kernel_name = 'hybrid_mla_hgrn2_hiermoe_block'


def rmsnorm(x, g):
    x32 = x.astype(jnp.float32)
    y = x32 * lax.rsqrt(jnp.mean(x32 * x32, axis=-1, keepdims=True) + EPS)
    return (y * g.astype(jnp.float32)).astype(x.dtype)


def rope_tables(L):
    inv = ROPE_BASE ** (-jnp.arange(0, MLA_ROPE, 2, dtype=jnp.float32) / MLA_ROPE)
    ang = jnp.arange(L, dtype=jnp.float32)[:, None] * inv[None, :]
    return jnp.cos(ang), jnp.sin(ang)


def apply_rope(x, cos, sin):
    x1, x2 = jnp.split(x.astype(jnp.float32), 2, axis=-1)
    return jnp.concatenate([x1 * cos - x2 * sin, x2 * cos + x1 * sin], axis=-1).astype(x.dtype)


def mla_branch(c_q, c_kv, k_pe, q_norm, w_uq, kv_norm, w_ukv, cos, sin):
    B, L, _ = c_q.shape
    q = (rmsnorm(c_q, q_norm) @ w_uq).reshape(B, L, MLA_HEADS, MLA_NOPE + MLA_ROPE)
    q_nope, q_pe = q[..., :MLA_NOPE], q[..., MLA_NOPE:]
    q_pe = apply_rope(q_pe, cos[:, None, :], sin[:, None, :])
    kv = (rmsnorm(c_kv, kv_norm) @ w_ukv).reshape(B, L, MLA_HEADS, MLA_NOPE + MLA_V)
    k_nope, v = kv[..., :MLA_NOPE], kv[..., MLA_NOPE:]
    k_pe = apply_rope(k_pe, cos, sin)
    k_idx = jnp.arange(L)
    scale = (MLA_NOPE + MLA_ROPE) ** -0.5

    def attend(qn, qp, q_idx):
        s = jnp.einsum('bqhd,bkhd->bhqk', qn, k_nope) + jnp.einsum('bqhd,bkd->bhqk', qp, k_pe)
        s = s.astype(jnp.float32) * scale
        s = jnp.where(k_idx[None, :] <= q_idx[:, None], s, -jnp.inf)
        p = jax.nn.softmax(s, axis=-1).astype(v.dtype)
        return jnp.einsum('bhqk,bkhd->bqhd', p, v)

    o_meta = attend(q_nope[:, :N_META], q_pe[:, :N_META], k_idx[:N_META])
    n_blk = (L - N_META) // Q_BLOCK

    def to_blocks(t):
        return jnp.moveaxis(t[:, N_META:].reshape(B, n_blk, Q_BLOCK, *t.shape[2:]), 1, 0)

    idx_blocks = jnp.arange(N_META, L).reshape(n_blk, Q_BLOCK)
    o_blocks = lax.map(lambda a: attend(*a), (to_blocks(q_nope), to_blocks(q_pe), idx_blocks))
    o_real = jnp.moveaxis(o_blocks, 0, 1).reshape(B, L - N_META, MLA_HEADS, MLA_V)
    return jnp.concatenate([o_meta, o_real], axis=1).reshape(B, L, MLA_WIDTH)


def hgrn2_branch(q_raw, f_raw, i_raw, g_raw, lb, hg_norm):
    B, L, _ = q_raw.shape
    f32 = jnp.float32
    f = lb.astype(f32) + (1.0 - lb.astype(f32)) * jax.nn.sigmoid(f_raw.astype(f32))
    log_f = jnp.log(f)
    k = 1.0 - f
    q = jax.nn.silu(q_raw.astype(f32))
    v = i_raw.astype(f32)
    pad = HG_CHUNK - N_META
    n_c = (L + pad) // HG_CHUNK

    def heads(t, d):
        t = t.reshape(B, L, HG_HEADS, d).transpose(0, 2, 1, 3)
        t = jnp.pad(t, ((0, 0), (0, 0), (pad, 0), (0, 0)))
        return jnp.moveaxis(t.reshape(B, HG_HEADS, n_c, HG_CHUNK, d), 2, 0)

    qc, kc, vc, lfc = heads(q, HG_DK), heads(k, HG_DK), heads(v, HG_DV), heads(log_f, HG_DK)
    causal = jnp.tril(jnp.ones((HG_CHUNK, HG_CHUNK), dtype=bool))

    def chunk_step(S, inp):
        q_c, k_c, v_c, lf_c = inp
        b = jnp.cumsum(lf_c, axis=2)
        o_inter = jnp.einsum('bhtk,bhkv->bhtv', q_c * jnp.exp(b), S)
        rel = b[:, :, :, None, :] - b[:, :, None, :, :]
        decay = jnp.exp(jnp.where(causal[:, :, None], rel, -jnp.inf))
        A = jnp.einsum('bhtk,bhsk,bhtsk->bhts', q_c, k_c, decay)
        o_c = o_inter + jnp.einsum('bhts,bhsv->bhtv', A, v_c)
        b_end = b[:, :, -1:, :]
        S_new = jnp.exp(b_end[:, :, 0, :, None]) * S + jnp.einsum(
            'bhsk,bhsv->bhkv', k_c * jnp.exp(b_end - b), v_c)
        return S_new, o_c

    S0 = jnp.zeros((B, HG_HEADS, HG_DK, HG_DV), f32)
    _, o = lax.scan(chunk_step, S0, (qc, kc, vc, lfc))
    o = jnp.moveaxis(o, 0, 2).reshape(B, HG_HEADS, n_c * HG_CHUNK, HG_DV)[:, :, pad:]
    o = o.transpose(0, 2, 1, 3)
    o = o * lax.rsqrt(jnp.mean(o * o, axis=-1, keepdims=True) + EPS)
    o = o.reshape(B, L, HG_WIDTH) * hg_norm.astype(f32) * jax.nn.silu(g_raw.astype(f32))
    return o.astype(q_raw.dtype)


def hier_moe(xf, w_group, b_group, w_route, b_route, w1, w3, w2):
    N, D = xf.shape
    g_logits = (xf @ w_group + b_group).astype(jnp.float32)
    p_group = jax.nn.softmax(g_logits, axis=-1)
    g_sel = jnp.argmax(g_logits, axis=-1)
    p_sel = jnp.take_along_axis(p_group, g_sel[:, None], axis=-1)
    e_logits = (xf @ w_route + b_route).astype(jnp.float32).reshape(N, N_GROUPS, EXPERTS_PER_GROUP)
    e_in_group = jnp.take_along_axis(e_logits, g_sel[:, None, None], axis=1)[:, 0]
    top_val, top_idx = lax.top_k(e_in_group, TOP_K)
    gate = (p_sel * jax.nn.softmax(top_val, axis=-1)).astype(xf.dtype)
    expert = g_sel[:, None] * EXPERTS_PER_GROUP + top_idx

    A = N * TOP_K
    flat_e = expert.reshape(A)
    flat_tok = jnp.broadcast_to(jnp.arange(N, dtype=jnp.int32)[:, None], (N, TOP_K)).reshape(A)
    flat_w = gate.reshape(A)
    order = jnp.argsort(flat_e)
    e_sorted = flat_e[order]
    counts = jnp.bincount(flat_e, length=N_EXPERTS)
    start = jnp.cumsum(counts) - counts
    padded = (counts + MOE_BLOCK - 1) // MOE_BLOCK * MOE_BLOCK
    p_end = jnp.cumsum(padded)
    p_start = p_end - padded
    dest = p_start[e_sorted] + (jnp.arange(A) - start[e_sorted])
    n_blocks = -(-A // MOE_BLOCK) + N_EXPERTS
    R = n_blocks * MOE_BLOCK
    buf_tok = jnp.full((R,), N, dtype=jnp.int32).at[dest].set(flat_tok[order])
    buf_w = jnp.zeros((R,), xf.dtype).at[dest].set(flat_w[order])
    blk_expert = jnp.minimum(
        jnp.searchsorted(p_end, jnp.arange(n_blocks) * MOE_BLOCK, side='right'), N_EXPERTS - 1)
    x_pad = jnp.concatenate([xf, jnp.zeros((1, D), xf.dtype)], axis=0)

    def expert_block(args):
        tok, e = args
        xb = x_pad[tok]
        hdn = jax.nn.silu(xb @ w1[e]) * (xb @ w3[e])
        return hdn @ w2[e]

    y = lax.map(expert_block, (buf_tok.reshape(n_blocks, MOE_BLOCK), blk_expert))
    y = y.reshape(R, D) * buf_w[:, None]
    return jnp.zeros((N + 1, D), xf.dtype).at[buf_tok].add(y)[:N]


def setup_inputs(seed: int = 0) -> dict:
    key = jax.random.key(seed)
    ks = jax.random.split(key, 24)
    f32 = jnp.float32

    def nrm(k, shape, scale):
        return jax.random.normal(k, shape, f32) * scale

    def gain(k, shape):
        return 1.0 + 0.02 * jax.random.normal(k, shape, f32)

    return {
        'x': nrm(ks[0], (BATCH, SEQ, D_MODEL), 1.0),
        'meta_tokens': nrm(ks[1], (N_META, D_MODEL), 1.0),
        'attn_norm': gain(ks[2], (DEPTH, D_MODEL)),
        'w_in': nrm(ks[3], (DEPTH, D_MODEL, D_IN), D_MODEL ** -0.5),
        'q_norm': gain(ks[4], (DEPTH, Q_LORA)),
        'w_uq': nrm(ks[5], (DEPTH, Q_LORA, MLA_HEADS * (MLA_NOPE + MLA_ROPE)), Q_LORA ** -0.5),
        'kv_norm': gain(ks[6], (DEPTH, KV_LORA)),
        'w_ukv': nrm(ks[7], (DEPTH, KV_LORA, MLA_HEADS * (MLA_NOPE + MLA_V)), KV_LORA ** -0.5),
        'lb_table': nrm(ks[8], (DEPTH + 1, HG_FWIDTH), 0.5),
        'hg_norm': gain(ks[9], (DEPTH, HG_WIDTH)),
        'w_br_mla': nrm(ks[10], (DEPTH, MLA_WIDTH, D_MODEL), MLA_WIDTH ** -0.5),
        'w_br_hgrn': nrm(ks[11], (DEPTH, HG_WIDTH, D_MODEL), HG_WIDTH ** -0.5),
        'b_gate': nrm(ks[12], (DEPTH, 2, D_MODEL), 0.02),
        'w_out': nrm(ks[13], (DEPTH, D_MODEL, D_MODEL), D_MODEL ** -0.5),
        'ffn_norm': gain(ks[14], (DEPTH, D_MODEL)),
        'w_group': nrm(ks[15], (DEPTH, D_MODEL, N_GROUPS), D_MODEL ** -0.5),
        'b_group': nrm(ks[16], (DEPTH, N_GROUPS), 0.01),
        'w_route': nrm(ks[17], (DEPTH, D_MODEL, N_EXPERTS), D_MODEL ** -0.5),
        'b_route': nrm(ks[18], (DEPTH, N_EXPERTS), 0.01),
        'w1': nrm(ks[19], (DEPTH, N_EXPERTS, D_MODEL, D_EXPERT), D_MODEL ** -0.5),
        'w3': nrm(ks[20], (DEPTH, N_EXPERTS, D_MODEL, D_EXPERT), D_MODEL ** -0.5),
        'w2': nrm(ks[21], (DEPTH, N_EXPERTS, D_EXPERT, D_MODEL), D_EXPERT ** -0.5),
        'final_norm': gain(ks[22], (D_MODEL,)),
    }


def reference(x, meta_tokens, attn_norm, w_in, q_norm, w_uq, kv_norm, w_ukv, lb_table, hg_norm,
              w_br_mla, w_br_hgrn, b_gate, w_out, ffn_norm, w_group, b_group, w_route, b_route,
              w1, w3, w2, final_norm):
    B, S, D = x.shape
    L = S + N_META
    h = jnp.concatenate([jnp.broadcast_to(meta_tokens[None].astype(x.dtype), (B, N_META, D)), x], axis=1)
    cos, sin = rope_tables(L)
    lbs = jnp.cumsum(jax.nn.softmax(lb_table.astype(jnp.float32), axis=0), axis=0)
    split_idx = [int(c) for c in np.cumsum(IN_SIZES)[:-1]]
    for l in range(DEPTH):
        u = rmsnorm(h, attn_norm[l])
        proj = u @ w_in[l]
        c_q, c_kv, k_pe, hq, hf, hi, hg, gm, gh = jnp.split(proj, split_idx, axis=-1)
        o_mla = mla_branch(c_q, c_kv, k_pe, q_norm[l], w_uq[l], kv_norm[l], w_ukv[l], cos, sin)
        o_hg = hgrn2_branch(hq, hf, hi, hg, lbs[l], hg_norm[l])
        gate_m = jax.nn.sigmoid(gm + b_gate[l, 0])
        gate_h = jax.nn.sigmoid(gh + b_gate[l, 1])
        merged = gate_m * (o_mla @ w_br_mla[l]) + gate_h * (o_hg @ w_br_hgrn[l])
        h = h + merged @ w_out[l]
        u = rmsnorm(h, ffn_norm[l])
        h = h + hier_moe(u.reshape(B * L, D), w_group[l], b_group[l], w_route[l], b_route[l],
                         w1[l], w3[l], w2[l]).reshape(B, L, D)
    return rmsnorm(h, final_norm)[:, N_META:]
```

```cpp
#include <hip/hip_runtime.h>
#include <cstdio>
#include <cstdint>

#define L_ 2064
#define SEQ_ 2048
#define NB_ 8
#define NTOK (NB_ * L_)
#define DM 1024
#define DIN 4768
#define EPS_ 1e-6f

__device__ __forceinline__ float wave_sum(float v) {
#pragma unroll
    for (int o = 32; o > 0; o >>= 1) v += __shfl_xor(v, o);
    return v;
}
__device__ __forceinline__ float wave_max(float v) {
#pragma unroll
    for (int o = 32; o > 0; o >>= 1) v = fmaxf(v, __shfl_xor(v, o));
    return v;
}
__device__ __forceinline__ float block_sum256(float v, float* red) {
    v = wave_sum(v);
    __syncthreads();
    if ((threadIdx.x & 63) == 0) red[threadIdx.x >> 6] = v;
    __syncthreads();
    return red[0] + red[1] + red[2] + red[3];
}
__device__ __forceinline__ const float* h0row(const float* x, const float* meta, int n) {
    const int b = n / L_, t = n - b * L_;
    return t < 16 ? meta + (size_t)t * DM : x + ((size_t)b * SEQ_ + (t - 16)) * DM;
}
__device__ __forceinline__ float sigmoidf_(float v) { return 1.0f / (1.0f + expf(-v)); }
__device__ __forceinline__ float siluf_(float v) { return v / (1.0f + expf(-v)); }

__global__ void __launch_bounds__(256) k_rms_h0(const float* x, const float* meta, const float* g, float* out, int n0) {
    __shared__ float red[4];
    const int r = blockIdx.x, n = n0 + r;
    const float* src = h0row(x, meta, n);
    float v[4]; float ss = 0.f;
#pragma unroll
    for (int i = 0; i < 4; ++i) { v[i] = src[threadIdx.x + 256 * i]; ss += v[i] * v[i]; }
    ss = block_sum256(ss, red);
    const float rs = rsqrtf(ss * (1.0f / DM) + EPS_);
#pragma unroll
    for (int i = 0; i < 4; ++i) out[(size_t)r * DM + threadIdx.x + 256 * i] = v[i] * rs * g[threadIdx.x + 256 * i];
}
__global__ void __launch_bounds__(256) k_rms_rows(const float* in, int ldi, const float* g, float* out, int ldo, int W) {
    __shared__ float red[4];
    const int r = blockIdx.x;
    float ss = 0.f;
    for (int c = threadIdx.x; c < W; c += 256) { const float v = in[(size_t)r * ldi + c]; ss += v * v; }
    ss = block_sum256(ss, red);
    const float rs = rsqrtf(ss / (float)W + EPS_);
    for (int c = threadIdx.x; c < W; c += 256) out[(size_t)r * ldo + c] = in[(size_t)r * ldi + c] * rs * g[c];
}
__global__ void __launch_bounds__(256) k_gemm(const float* A, int lda, const float* B, int ldb, float* C, int ldc, int M, int N, int K) {
    __shared__ float As[16][68];
    __shared__ float Bs[16][68];
    const int tid = threadIdx.x, tx = tid & 15, ty = tid >> 4;
    const int row0 = blockIdx.y * 64, col0 = blockIdx.x * 64;
    float acc[4][4];
#pragma unroll
    for (int i = 0; i < 4; ++i)
#pragma unroll
        for (int j = 0; j < 4; ++j) acc[i][j] = 0.f;
    for (int k0 = 0; k0 < K; k0 += 16) {
#pragma unroll
        for (int i = 0; i < 4; ++i) {
            const int idx = tid + 256 * i;
            { const int r = idx >> 4, kk = idx & 15; const int gr = row0 + r; As[kk][r] = gr < M ? A[(size_t)gr * lda + k0 + kk] : 0.f; }
            { const int kk = idx >> 6, c = idx & 63; const int gc = col0 + c; Bs[kk][c] = gc < N ? B[(size_t)(k0 + kk) * ldb + gc] : 0.f; }
        }
        __syncthreads();
#pragma unroll
        for (int kk = 0; kk < 16; ++kk) {
            float a[4], b[4];
#pragma unroll
            for (int i = 0; i < 4; ++i) { a[i] = As[kk][ty * 4 + i]; b[i] = Bs[kk][tx * 4 + i]; }
#pragma unroll
            for (int i = 0; i < 4; ++i)
#pragma unroll
                for (int j = 0; j < 4; ++j) acc[i][j] += a[i] * b[j];
        }
        __syncthreads();
    }
#pragma unroll
    for (int i = 0; i < 4; ++i) {
        const int gr = row0 + ty * 4 + i;
        if (gr < M) {
#pragma unroll
            for (int j = 0; j < 4; ++j) { const int gc = col0 + tx * 4 + j; if (gc < N) C[(size_t)gr * ldc + gc] = acc[i][j]; }
        }
    }
}
__global__ void __launch_bounds__(256) k_rope_q(float* q, int n0, int rows) {
    const int idx = blockIdx.x * 256 + threadIdx.x;
    if (idx >= rows * 8 * 16) return;
    const int j = idx & 15, h = (idx >> 4) & 7, r = idx >> 7;
    const int t = (n0 + r) % L_;
    const float inv = powf(10000.0f, -(float)(2 * j) / 32.0f);
    const float ang = (float)t * inv;
    const float c = cosf(ang), s = sinf(ang);
    float* p = q + (size_t)r * 768 + h * 96 + 64;
    const float x1 = p[j], x2 = p[j + 16];
    p[j] = x1 * c - x2 * s; p[j + 16] = x2 * c + x1 * s;
}
__global__ void __launch_bounds__(256) k_rope_k(const float* proj, float* kpe, int n0, int rows) {
    const int idx = blockIdx.x * 256 + threadIdx.x;
    if (idx >= rows * 16) return;
    const int j = idx & 15, r = idx >> 4;
    const int t = (n0 + r) % L_;
    const float inv = powf(10000.0f, -(float)(2 * j) / 32.0f);
    const float ang = (float)t * inv;
    const float c = cosf(ang), s = sinf(ang);
    const float* p = proj + (size_t)r * DIN + 640;
    const float x1 = p[j], x2 = p[j + 16];
    kpe[(size_t)r * 32 + j] = x1 * c - x2 * s; kpe[(size_t)r * 32 + j + 16] = x2 * c + x1 * s;
}
__global__ void __launch_bounds__(64) k_attn(const float* q, const float* kv, const float* kpe, float* omla  ) {
    __shared__ float sq[96];
    const int r = blockIdx.x, h = blockIdx.y, lane = threadIdx.x;
    const int t = r % L_, rb = r - t;
    for (int d = lane; d < 96; d += 64) sq[d] = q[(size_t)r * 768 + h * 96 + d];
    __syncthreads();
    const float scale = 0.10206207261596575f;
    float m = -3.0e38f;
    for (int j = lane; j <= t; j += 64) {
        const float* kr = kv + (size_t)(rb + j) * 1024 + h * 128;
        const float* pr = kpe + (size_t)(rb + j) * 32;
        float s = 0.f;
        for (int d = 0; d < 64; ++d) s += sq[d] * kr[d];
        for (int d = 0; d < 32; ++d) s += sq[64 + d] * pr[d];
        m = fmaxf(m, s * scale);
    }
    m = wave_max(m);
    float l = 0.f; float acc[64];
#pragma unroll
    for (int d = 0; d < 64; ++d) acc[d] = 0.f;
    for (int j = lane; j <= t; j += 64) {
        const float* kr = kv + (size_t)(rb + j) * 1024 + h * 128;
        const float* pr = kpe + (size_t)(rb + j) * 32;
        float s = 0.f;
        for (int d = 0; d < 64; ++d) s += sq[d] * kr[d];
        for (int d = 0; d < 32; ++d) s += sq[64 + d] * pr[d];
        const float p = expf(s * scale - m);
        l += p;
#pragma unroll
        for (int d = 0; d < 64; ++d) acc[d] += p * kr[64 + d];
    }
    l = wave_sum(l);
    float outv = 0.f;
#pragma unroll
    for (int d = 0; d < 64; ++d) { const float v = wave_sum(acc[d]); if (lane == d) outv = v; }
    omla[(size_t)r * 512 + h * 64 + lane] = outv / l;
}
__global__ void __launch_bounds__(128) k_hgrn(const float* proj, const float* lb_table, float* oraw) {
    __shared__ float sf[128], sk[128], sq[128];
    const int bl = blockIdx.x, h = blockIdx.y, v = threadIdx.x;
    const int ch = h * 128 + v;
    const float t0 = lb_table[ch], t1 = lb_table[512 + ch];
    const float mx = fmaxf(t0, t1);
    const float lb = expf(t0 - mx) / (expf(t0 - mx) + expf(t1 - mx));
    float S[128];
#pragma unroll
    for (int k = 0; k < 128; ++k) S[k] = 0.f;
    for (int t = 0; t < L_; ++t) {
        const float* pr = proj + (size_t)(bl * L_ + t) * DIN;
        const float qr = pr[672 + ch], fr = pr[1184 + ch], vi = pr[1696 + ch];
        const float f = lb + (1.0f - lb) * sigmoidf_(fr);
        __syncthreads();
        sf[v] = f; sk[v] = 1.0f - f; sq[v] = siluf_(qr);
        __syncthreads();
        float o = 0.f;
#pragma unroll
        for (int k = 0; k < 128; ++k) { S[k] = sf[k] * S[k] + sk[k] * vi; o += sq[k] * S[k]; }
        oraw[(size_t)(bl * L_ + t) * 512 + ch] = o;
    }
}
__global__ void __launch_bounds__(128) k_hgrn_norm(const float* oraw, const float* proj, const float* hg_norm, float* ohg) {
    __shared__ float red[2];
    const int r = blockIdx.x, h = blockIdx.y, v = threadIdx.x, ch = h * 128 + v;
    const float o = oraw[(size_t)r * 512 + ch];
    float ss = wave_sum(o * o);
    if ((v & 63) == 0) red[v >> 6] = ss;
    __syncthreads();
    ss = red[0] + red[1];
    const float rs = rsqrtf(ss * (1.0f / 128.0f) + EPS_);
    const float g = proj[(size_t)r * DIN + 2208 + ch];
    ohg[(size_t)r * 512 + ch] = o * rs * hg_norm[ch] * siluf_(g);
}
__global__ void __launch_bounds__(256) k_merge(const float* proj, const float* bg, const float* ym, const float* yh, float* merged) {
    const int r = blockIdx.x;
    for (int c = threadIdx.x; c < DM; c += 256) {
        const float gm = sigmoidf_(proj[(size_t)r * DIN + 2720 + c] + bg[c]);
        const float gh = sigmoidf_(proj[(size_t)r * DIN + 3744 + c] + bg[DM + c]);
        merged[(size_t)r * DM + c] = gm * ym[(size_t)r * DM + c] + gh * yh[(size_t)r * DM + c];
    }
}
__global__ void __launch_bounds__(256) k_resid(const float* x, const float* meta, const float* y, float* h1) {
    const int n = blockIdx.x;
    const float* src = h0row(x, meta, n);
    for (int c = threadIdx.x; c < DM; c += 256) h1[(size_t)n * DM + c] = src[c] + y[(size_t)n * DM + c];
}
__global__ void __launch_bounds__(256) k_router(const float* h1, const float* g, const float* wg, const float* bgp, const float* wr, const float* br,
                                                float* u2, int* eidx, float* egate) {
    __shared__ float red[4];
    __shared__ float su[DM];
    __shared__ float lg[72];
    const int n = blockIdx.x, tid = threadIdx.x, lane = tid & 63, w = tid >> 6;
    float v[4]; float ss = 0.f;
#pragma unroll
    for (int i = 0; i < 4; ++i) { v[i] = h1[(size_t)n * DM + tid + 256 * i]; ss += v[i] * v[i]; }
    ss = block_sum256(ss, red);
    const float rs = rsqrtf(ss * (1.0f / DM) + EPS_);
#pragma unroll
    for (int i = 0; i < 4; ++i) { const float uu = v[i] * rs * g[tid + 256 * i]; su[tid + 256 * i] = uu; u2[(size_t)n * DM + tid + 256 * i] = uu; }
    __syncthreads();
    for (int l = w; l < 72; l += 4) {
        float s = 0.f;
        if (l < 8) { for (int d = lane; d < DM; d += 64) s += su[d] * wg[(size_t)d * 8 + l]; }
        else { for (int d = lane; d < DM; d += 64) s += su[d] * wr[(size_t)d * 64 + (l - 8)]; }
        s = wave_sum(s);
        if (lane == 0) lg[l] = s + (l < 8 ? bgp[l] : br[l - 8]);
    }
    __syncthreads();
    if (tid == 0) {
        int gs = 0; float gm = lg[0];
        for (int i = 1; i < 8; ++i) if (lg[i] > gm) { gm = lg[i]; gs = i; }
        float den = 0.f;
        for (int i = 0; i < 8; ++i) den += expf(lg[i] - gm);
        const float psel = 1.0f / den;
        const float* el = lg + 8 + gs * 8;
        int i0 = 0; float v0 = el[0];
        for (int i = 1; i < 8; ++i) if (el[i] > v0) { v0 = el[i]; i0 = i; }
        int i1 = -1; float v1 = -3.0e38f;
        for (int i = 0; i < 8; ++i) if (i != i0 && el[i] > v1) { v1 = el[i]; i1 = i; }
        const float e1 = expf(v1 - v0);
        const float w0 = 1.0f / (1.0f + e1), w1 = e1 / (1.0f + e1);
        eidx[n * 2 + 0] = gs * 8 + i0; eidx[n * 2 + 1] = gs * 8 + i1;
        egate[n * 2 + 0] = psel * w0; egate[n * 2 + 1] = psel * w1;
    }
}
__global__ void __launch_bounds__(256) k_expert(const float* u2, const int* eidx, const float* egate, const float* w1, const float* w3, const float* w2, float* moe) {
    __shared__ float sx[DM];
    __shared__ float sh[256];
    const int a = blockIdx.x, n = a >> 1, tid = threadIdx.x;
    const int e = eidx[a]; const float gate = egate[a];
    for (int d = tid; d < DM; d += 256) sx[d] = u2[(size_t)n * DM + d];
    __syncthreads();
    const float* p1 = w1 + (size_t)e * DM * 256 + tid;
    const float* p3 = w3 + (size_t)e * DM * 256 + tid;
    float a1 = 0.f, a3 = 0.f;
    for (int d = 0; d < DM; ++d) { a1 += sx[d] * p1[(size_t)d * 256]; a3 += sx[d] * p3[(size_t)d * 256]; }
    sh[tid] = siluf_(a1) * a3;
    __syncthreads();
    const float* p2 = w2 + (size_t)e * 256 * DM;
#pragma unroll
    for (int i = 0; i < 4; ++i) {
        const int c = tid + 256 * i; float s = 0.f;
        for (int j = 0; j < 256; ++j) s += sh[j] * p2[(size_t)j * DM + c];
        atomicAdd(&moe[(size_t)n * DM + c], gate * s);
    }
}
__global__ void __launch_bounds__(256) k_final(const float* h1, const float* moe, const float* g, float* out) {
    __shared__ float red[4];
    const int bs = blockIdx.x, b = bs / SEQ_, s = bs - b * SEQ_, n = b * L_ + 16 + s, tid = threadIdx.x;
    float v[4]; float ss = 0.f;
#pragma unroll
    for (int i = 0; i < 4; ++i) { v[i] = h1[(size_t)n * DM + tid + 256 * i] + moe[(size_t)n * DM + tid + 256 * i]; ss += v[i] * v[i]; }
    ss = block_sum256(ss, red);
    const float rs = rsqrtf(ss * (1.0f / DM) + EPS_);
#pragma unroll
    for (int i = 0; i < 4; ++i) out[(size_t)bs * DM + tid + 256 * i] = v[i] * rs * g[tid + 256 * i];
}

static void gemm(const float* A, int lda, const float* B, int ldb, float* C, int ldc, int M, int N, int K, hipStream_t s) {
    dim3 grid((N + 63) / 64, (M + 63) / 64);
    k_gemm<<<grid, 256, 0, s>>>(A, lda, B, ldb, C, ldc, M, N, K);
}

extern "C" void kernel_launch(void* const* d_in, const int* in_sizes, int n_in, void* d_out, int out_size, void* d_ws, size_t ws_size, hipStream_t stream) {
    const float* x = (const float*)d_in[0];
    const float* meta = (const float*)d_in[1];
    const float* attn_norm = (const float*)d_in[2];
    const float* w_in = (const float*)d_in[3];
    const float* q_norm = (const float*)d_in[4];
    const float* w_uq = (const float*)d_in[5];
    const float* kv_norm = (const float*)d_in[6];
    const float* w_ukv = (const float*)d_in[7];
    const float* lb_table = (const float*)d_in[8];
    const float* hg_norm = (const float*)d_in[9];
    const float* w_br_mla = (const float*)d_in[10];
    const float* w_br_hgrn = (const float*)d_in[11];
    const float* b_gate = (const float*)d_in[12];
    const float* w_out = (const float*)d_in[13];
    const float* ffn_norm = (const float*)d_in[14];
    const float* w_group = (const float*)d_in[15];
    const float* b_group = (const float*)d_in[16];
    const float* w_route = (const float*)d_in[17];
    const float* b_route = (const float*)d_in[18];
    const float* w1 = (const float*)d_in[19];
    const float* w3 = (const float*)d_in[20];
    const float* w2 = (const float*)d_in[21];
    const float* final_norm = (const float*)d_in[22];
    float* out = (float*)d_out;

    const int RQ = L_;
    float* ws = (float*)d_ws;
    size_t off = 0;
    auto carve = [&](size_t n) { float* p = ws + off; off += (n + 63) & ~(size_t)63; return p; };
    float* merged = carve((size_t)NTOK * DM);
    float* h1     = carve((size_t)NTOK * DM);
    float* regC   = ws + off;
    float* u_p    = carve((size_t)RQ * DM);
    float* proj_p = carve((size_t)RQ * DIN);
    float* cqn_p  = carve((size_t)RQ * 384);
    float* q_p    = carve((size_t)RQ * 768);
    float* ckvn_p = carve((size_t)RQ * 256);
    float* kv_p   = carve((size_t)RQ * 1024);
    float* kpe_p  = carve((size_t)RQ * 32);
    float* omla_p = carve((size_t)RQ * 512);
    float* oraw_p = carve((size_t)RQ * 512);
    float* ohg_p  = carve((size_t)RQ * 512);
    float* ym_p   = carve((size_t)RQ * DM);
    float* yh_p   = carve((size_t)RQ * DM);
    if ((size_t)((ws + off) - regC) < (size_t)NTOK * DM) off = (size_t)(regC - ws) + (size_t)NTOK * DM;
    int*   eidx   = (int*)carve((size_t)NTOK * 2);
    float* egate  = carve((size_t)NTOK * 2);
    if (off * 4 > ws_size) { fprintf(stderr, "ws too small: need %zu have %zu\n", off * 4, ws_size); return; }
    float* u2 = merged;
    float* moe = regC;

    for (int pass = 0; pass < NB_; ++pass) {
        const int n0 = pass * RQ;
        k_rms_h0<<<RQ, 256, 0, stream>>>(x, meta, attn_norm, u_p, n0);
        gemm(u_p, DM, w_in, DIN, proj_p, DIN, RQ, DIN, DM, stream);
        k_rms_rows<<<RQ, 256, 0, stream>>>(proj_p, DIN, q_norm, cqn_p, 384, 384);
        gemm(cqn_p, 384, w_uq, 768, q_p, 768, RQ, 768, 384, stream);
        k_rope_q<<<(RQ * 128 + 255) / 256, 256, 0, stream>>>(q_p, n0, RQ);
        k_rms_rows<<<RQ, 256, 0, stream>>>(proj_p + 384, DIN, kv_norm, ckvn_p, 256, 256);
        gemm(ckvn_p, 256, w_ukv, 1024, kv_p, 1024, RQ, 1024, 256, stream);
        k_rope_k<<<(RQ * 16 + 255) / 256, 256, 0, stream>>>(proj_p, kpe_p, n0, RQ);
        k_attn<<<dim3(RQ, 8), 64, 0, stream>>>(q_p, kv_p, kpe_p, omla_p);
        k_hgrn<<<dim3(1, 4), 128, 0, stream>>>(proj_p, lb_table, oraw_p);
        k_hgrn_norm<<<dim3(RQ, 4), 128, 0, stream>>>(oraw_p, proj_p, hg_norm, ohg_p);
        gemm(omla_p, 512, w_br_mla, DM, ym_p, DM, RQ, DM, 512, stream);
        gemm(ohg_p, 512, w_br_hgrn, DM, yh_p, DM, RQ, DM, 512, stream);
        k_merge<<<RQ, 256, 0, stream>>>(proj_p, b_gate, ym_p, yh_p, merged + (size_t)n0 * DM);
    }
    float* tmp = regC;
    gemm(merged, DM, w_out, DM, tmp, DM, NTOK, DM, DM, stream);
    k_resid<<<NTOK, 256, 0, stream>>>(x, meta, tmp, h1);
    k_router<<<NTOK, 256, 0, stream>>>(h1, ffn_norm, w_group, b_group, w_route, b_route, u2, eidx, egate);
    hipMemsetAsync(moe, 0, (size_t)NTOK * DM * 4, stream);
    k_expert<<<NTOK * 2, 256, 0, stream>>>(u2, eidx, egate, w1, w3, w2, moe);
    k_final<<<NB_ * SEQ_, 256, 0, stream>>>(h1, moe, final_norm, out);
}
```

```cpp
#include <hip/hip_runtime.h>
#include <cstdio>
#include <cstdint>

#define L_ 2064
#define SEQ_ 2048
#define NB_ 8
#define NTOK (NB_ * L_)
#define DM 1024
#define DIN 4768
#define EPS_ 1e-6f

#define N_LAUNCH_SPLIT 0
#include <hip/hip_cooperative_groups.h>
namespace cg = cooperative_groups;

#define GAS __attribute__((address_space(1)))
#define LAS __attribute__((address_space(3)))
typedef unsigned short bf16;
typedef unsigned v4u __attribute__((ext_vector_type(4)));
typedef unsigned v2u __attribute__((ext_vector_type(2)));
typedef float f32x4 __attribute__((ext_vector_type(4)));
typedef float f32x2 __attribute__((ext_vector_type(2)));
typedef short bf16x8 __attribute__((ext_vector_type(8)));
#define LDS_WAIT() asm volatile("s_waitcnt lgkmcnt(0)" ::: "memory")
#define VM_WAIT() asm volatile("s_waitcnt vmcnt(0)" ::: "memory")
__device__ __forceinline__ unsigned f2bf(float f) { unsigned u = __builtin_bit_cast(unsigned, f); return (u + 0x7fffu + ((u >> 16) & 1u)) >> 16; }
__device__ __forceinline__ unsigned pk2(float lo, float hi) { return f2bf(lo) | (f2bf(hi) << 16); }
__device__ __forceinline__ float bf2f(unsigned h) { return __builtin_bit_cast(float, h << 16); }
__device__ __forceinline__ float bflo(unsigned w) { return __builtin_bit_cast(float, w << 16); }
__device__ __forceinline__ float bfhi(unsigned w) { return __builtin_bit_cast(float, w & 0xffff0000u); }

constexpr int NWAVES = 8, NTHR = 512;
constexpr int MP = 16640;
constexpr int MR = 16384;
constexpr int PJ = 4864;
constexpr int PJ_HQ = 768, PJ_HF = 1280, PJ_HI = 1792, PJ_HG = 2304, PJ_GM = 2816, PJ_GH = 3840;
constexpr float QSCALE = 0.10206207261596575f * 1.4426950408889634f;

constexpr size_t MiB = 1u << 20;
constexpr size_t WS_CTL = 0, CTL_ZERO_BYTES = 64 * 1024;
constexpr size_t WS_ROPE = 1 * MiB;
constexpr size_t WS_SSQ = WS_ROPE + 512 * 1024;
constexpr size_t WS_WIN = 4 * MiB;
constexpr size_t WS_WUQ = 14 * MiB;
constexpr size_t WS_WUKV = WS_WUQ + 768 * 384 * 2;
constexpr size_t WS_WBRM = WS_WUKV + 1024 * 256 * 2;
constexpr size_t WS_WBRH = WS_WBRM + 1024 * 512 * 2;
constexpr size_t WS_WOUT = WS_WBRH + 1024 * 512 * 2;
constexpr size_t WS_DEC = WS_WOUT + 1024 * 1024 * 2;
constexpr size_t WS_WRT = WS_DEC + 32 * 32 * 128 * 4 + 65536;
constexpr size_t WS_A_END = 20 * MiB;
static_assert(WS_WRT + 80 * 1024 * 4 <= WS_A_END, "region A (router weights)");
static_assert(WS_DEC + 32 * 32 * 128 * 4 <= WS_A_END, "region A");
constexpr size_t WS_B = WS_A_END;
constexpr size_t SZ_B = (size_t)MP * 1024 * 2;
constexpr size_t WS_C = WS_B + SZ_B;
constexpr size_t SZ_C = (size_t)MP * PJ * 2;
constexpr size_t WS_D = WS_C + SZ_C;
constexpr size_t WS_Q = WS_D, WS_K = WS_Q + (size_t)MP * 768 * 2, WS_V = WS_K + (size_t)MP * 768 * 2;
constexpr size_t WS_END = WS_V + (size_t)MP * 512 * 2;
static_assert(WS_END <= 298900000, "d_ws map");

constexpr int CW_BAR = 1024;
constexpr int CW_PROBE = 8000;

constexpr int RING_BYTES = 131072;
constexpr int LDSX_OFF = RING_BYTES;
constexpr int MISC_OFF = RING_BYTES + 12288;
constexpr int LDS_BYTES = 147456;

#define XB_TMO      128
#define XB_XCNT(j)  (256  + 64 * (j))
#define XB_XSUB(j)  (1280 + 64 * (j))
#define XB_XGEN(j)  (2304 + 64 * (j))
#define XB_TOP      3328
#define XB_TOPGEN   3392
#define XCD_BAR_WORDS 3456
#define XB_SPIN_CAP (1u << 18)
__device__ __forceinline__ unsigned xb_ld(unsigned* p)              { return __hip_atomic_load(p, __ATOMIC_RELAXED, __HIP_MEMORY_SCOPE_AGENT); }
__device__ __forceinline__ unsigned xb_add(unsigned* p, unsigned v) { return __hip_atomic_fetch_add(p, v, __ATOMIC_RELAXED, __HIP_MEMORY_SCOPE_AGENT); }
__device__ __forceinline__ unsigned xb_xcc_id() { return (unsigned)__builtin_amdgcn_s_getreg((3 << 11) | 20) & 0xFu; }
#define XB_SPIN(cond, bar) do { unsigned _sp = 0; while (cond) { __builtin_amdgcn_s_sleep(1); \
    if ((++_sp & 255u) == 0u) { if (xb_ld(&(bar)[XB_TMO])) break; if (_sp > XB_SPIN_CAP) { atomicAdd(&(bar)[XB_TMO], 1u); break; } } } } while (0)
struct XcdBarrier { unsigned* bar; unsigned x; volatile LAS unsigned* st; };
__device__ __forceinline__ XcdBarrier xcd_barrier_post(unsigned* bar, volatile LAS unsigned* st) {
    XcdBarrier b; b.bar = bar; b.x = xb_xcc_id(); b.st = st;
    if (threadIdx.x == 0) (void)xb_add(&bar[XB_XCNT(b.x)], 1u);
    return b;
}
__device__ __forceinline__ void xcd_barrier_complete(unsigned* bar, unsigned x, unsigned& nloc, unsigned& nx) {
    const unsigned G = gridDim.x * gridDim.y * gridDim.z;
    unsigned sum, cnt, mine, sp = 0u;
    for (;;) {
        sum = 0u; cnt = 0u; mine = 0u;
#pragma unroll
        for (unsigned j = 0; j < 16; ++j) { const unsigned c = xb_ld(&bar[XB_XCNT(j)]); sum += c; cnt += (c > 0u) ? 1u : 0u; mine = (j == x) ? c : mine; }
        if (sum == G) break;
        __builtin_amdgcn_s_sleep(1);
        if ((++sp & 255u) == 0u) { if (xb_ld(&bar[XB_TMO])) break; if (sp > XB_SPIN_CAP) { atomicAdd(&bar[XB_TMO], 1u); break; } }
    }
    nloc = mine > 0u ? mine : 1u; nx = cnt > 0u ? cnt : 1u;
}
__device__ __forceinline__ void xcd_barrier(const XcdBarrier& b) {
    asm volatile("s_waitcnt vmcnt(0)" ::: "memory");
    __syncthreads();
    if (threadIdx.x == 0) {
        unsigned* bar = b.bar;
        __builtin_amdgcn_s_waitcnt(0);
        unsigned nloc = b.st[0], nx = b.st[1];
        if (nloc == 0u) { xcd_barrier_complete(bar, b.x, nloc, nx); b.st[0] = nloc; b.st[1] = nx; }
        const unsigned old = xb_add(&bar[XB_XSUB(b.x)], 1u);
        const unsigned gen = old / nloc;
        if (old + 1u == (gen + 1u) * nloc) {
            __builtin_amdgcn_fence(__ATOMIC_RELEASE, "agent");
            asm volatile("s_waitcnt vmcnt(0)" ::: "memory");
            const unsigned og = xb_add(&bar[XB_TOP], 1u);
            const unsigned tg = og / nx;
            if (og + 1u == (tg + 1u) * nx) xb_add(&bar[XB_TOPGEN], 1u);
            else XB_SPIN(xb_ld(&bar[XB_TOPGEN]) == tg, bar);
            __builtin_amdgcn_fence(__ATOMIC_ACQUIRE, "agent");
            xb_add(&bar[XB_XGEN(b.x)], 1u);
            asm volatile("s_waitcnt vmcnt(0)" ::: "memory");
        } else {
            XB_SPIN(xb_ld(&bar[XB_XGEN(b.x)]) == gen, bar);
            __builtin_amdgcn_fence(__ATOMIC_ACQUIRE, "agent");
            asm volatile("s_waitcnt vmcnt(0)" ::: "memory");
        }
    }
    __syncthreads();
}

namespace pg8 {
#define PG8_LAS __attribute__((address_space(3)))
typedef unsigned short bf16_t;
constexpr int BM = 256, BK = 64, HALF = 128, HTB = HALF * BK * 2, STAGE_BYTES = 8 * HTB, NXCD = 8, WGM = 8;
__host__ __device__ __forceinline__ int lds_byte(int r, int c) { const int st = (r >> 4) * 2 + (c >> 5), rr = r & 15, cc = c & 31, ob = rr * 64 + cc * 2; return st * 1024 + (ob ^ (((ob >> 9) & 1) << 5)); }
__host__ __device__ __forceinline__ void stage_rc(int b, int& R, int& C) { const int st = b / 1024, sb = b % 1024, swz = sb ^ (((sb >> 9) & 1) << 5); R = (st >> 1) * 16 + swz / 64; C = (st & 1) * 32 + (swz % 64) / 2; }
__host__ __device__ __forceinline__ int perm32(int rho) { const int n = rho >> 4, i = rho & 15; return 8 * (i >> 2) + 4 * n + (i & 3); }

struct Unit { int pm, pn, aux, rows, lrow; size_t aoff, boff; };
struct Gemm { const bf16_t* A; const bf16_t* Bt; int lda, ksA, K; const int* glist; };

struct DenseOrder {
    int nM, nN, nwg, G, c, lda, K;
    __device__ void init(int nM_, int nN_, int G_, int c_, int lda_, int K_) { nM = nM_; nN = nN_; nwg = nM * nN; G = G_; c = c_; lda = lda_; K = K_; }
    __device__ bool next(int i, Unit& u) const {
        const long L = (long)i * G + c; if (L >= nwg) return false;
        int wgid = (int)L; { const int q = nwg / NXCD, r = nwg % NXCD, xcd = wgid % NXCD, off = wgid / NXCD; wgid = (xcd < r ? xcd * (q + 1) : r * (q + 1) + (xcd - r) * q) + off; }
        const int nig = WGM * nN, gid = wgid / nig, fm = gid * WGM, gsz = (nM - fm) < WGM ? (nM - fm) : WGM;
        u.pm = fm + ((wgid % nig) % gsz); u.pn = (wgid % nig) / gsz; u.aux = i; u.rows = 256; u.lrow = 0;
        u.aoff = (size_t)u.pm * BM * lda * 2; u.boff = (size_t)u.pn * BM * K * 2; return true;
    }
};

__device__ __forceinline__ unsigned cvt_pk_bf16(float lo, float hi) { unsigned r; asm volatile("v_cvt_pk_bf16_f32 %0, %1, %2" : "=v"(r) : "v"(lo), "v"(hi)); return r; }

template <class Epi, class Sched, bool GATHER = false, bool ALIGN_EPI = true, bool SP2 = true>
__device__ __forceinline__ void gemm_phase(PG8_LAS unsigned char* lds, const Gemm g, const Sched& S, const Epi& E) {
    const int tid = threadIdx.x, wid = __builtin_amdgcn_readfirstlane(tid >> 6), lane = tid & 63, wr = wid >> 2, wc = wid & 3, fr = lane & 15, fq = lane >> 4;
    const int K = g.K, nt = K / BK;
    unsigned voffA[2], voffA1[2], voffAn[2], voffA1n[2], voffB[2]; int gR[2], gC[2];
#pragma unroll
    for (int i = 0; i < 2; ++i) { int R, C; stage_rc(tid * 16 + i * 8192, R, C); const int Rb = Epi::PERM ? ((R & ~31) + perm32(R & 31)) : R; gR[i] = R; gC[i] = C;
        voffA[i] = (unsigned)(R * g.lda + C) * 2u; voffA1[i] = voffA[i] + (unsigned)(HALF * g.lda * 2); voffAn[i] = voffA[i]; voffA1n[i] = voffA1[i]; voffB[i] = (unsigned)(Rb * K + C) * 2u; }
    const size_t ksA = (size_t)g.ksA * 2, ksB = (size_t)(BK * 2);
    const size_t hsB = (size_t)HALF * K * 2;
#define PG8_GOFF(u, v0, v1) do { if constexpr (GATHER) { _Pragma("unroll") for (int i = 0; i < 2; ++i) { \
        const int r0 = gR[i], r1 = gR[i] + HALF; \
        const int t0 = r0 < (u).rows ? (g.glist[(u).lrow + r0] >> 1) : 0, t1 = r1 < (u).rows ? (g.glist[(u).lrow + r1] >> 1) : 0; \
        (v0)[i] = (unsigned)(t0 * g.lda + gC[i]) * 2u; (v1)[i] = (unsigned)(t1 * g.lda + gC[i]) * 2u; } } } while (0)
    const unsigned ldsw = (unsigned)wid * 1024u;
    const int aoff = lds_byte(wr * 64 + fr, fq * 8), boff = lds_byte(wc * 32 + fr, fq * 8);
#define PG8_SA(b, h) (((b) * 2 + (h)) * HTB)
#define PG8_SB(b, h) ((4 + (b) * 2 + (h)) * HTB)
#define PG8_STAGE(bufoff, gbase, voff) do { _Pragma("unroll") for (int _i = 0; _i < 2; ++_i) \
        __builtin_amdgcn_global_load_lds((const unsigned*)((const char*)(gbase) + (voff)[_i]), (PG8_LAS unsigned*)(lds + (bufoff) + ldsw + _i * 8192), 16, 0, 0); } while (0)
#define PG8_LDA(dst, b, h) do { _Pragma("unroll") for (int m = 0; m < 4; ++m) _Pragma("unroll") for (int k = 0; k < 2; ++k) dst[m][k] = *(const PG8_LAS bf16x8*)(lds + PG8_SA(b, h) + aoff + m * 2048 + k * 1024); } while (0)
#define PG8_LDB(dst, b, h) do { _Pragma("unroll") for (int n = 0; n < 2; ++n) _Pragma("unroll") for (int k = 0; k < 2; ++k) dst[n][k] = *(const PG8_LAS bf16x8*)(lds + PG8_SB(b, h) + boff + n * 2048 + k * 1024); } while (0)
#define PG8_MMA(ai, bj, At, Bt) do { __builtin_amdgcn_s_setprio(1); _Pragma("unroll") for (int m = 0; m < 4; ++m) _Pragma("unroll") for (int n = 0; n < 2; ++n) _Pragma("unroll") for (int k = 0; k < 2; ++k) \
        acc[ai][bj][m][n] = __builtin_amdgcn_mfma_f32_16x16x32_bf16(Bt[n][k], At[m][k], acc[ai][bj][m][n], 0, 0, 0); __builtin_amdgcn_s_setprio(0); } while (0)
#define PG8_WAIT_V(n) asm volatile("s_waitcnt vmcnt(" #n ")" ::: "memory")
#define PG8_WAIT_L(n) asm volatile("s_waitcnt lgkmcnt(" #n ")" ::: "memory")
#define PG8_BAR __builtin_amdgcn_s_barrier()
#define PG8_SCHED __builtin_amdgcn_sched_barrier(0)
    Unit cur, nxt; int ui = 0;
    if (!S.next(0, cur)) return;
    f32x4 acc[2][2][4][2];
#pragma unroll
    for (int a = 0; a < 2; ++a)
#pragma unroll
        for (int b = 0; b < 2; ++b)
#pragma unroll
            for (int m = 0; m < 4; ++m)
#pragma unroll
                for (int n = 0; n < 2; ++n) acc[a][b][m][n] = (f32x4){0.f, 0.f, 0.f, 0.f};
    bf16x8 At[4][2], B0[2][2], B1[2][2];
    const char* cA = (const char*)g.A + cur.aoff; const char* cB = (const char*)g.Bt + cur.boff;
    PG8_GOFF(cur, voffA, voffA1);
    static_assert(SP2, "only the SP2 schedule is kept");
    {
        PG8_STAGE(PG8_SB(0, 0), cB, voffB); PG8_STAGE(PG8_SB(0, 1), cB + hsB, voffB); PG8_STAGE(PG8_SA(0, 0), cA, voffA); PG8_STAGE(PG8_SA(0, 1), cA, voffA1);
        if (wr == 1) PG8_BAR;
        PG8_WAIT_V(2); PG8_BAR;
        PG8_STAGE(PG8_SB(1, 0), cB + ksB, voffB); PG8_STAGE(PG8_SA(1, 0), cA + ksA, voffA); PG8_STAGE(PG8_SB(1, 1), cB + hsB + ksB, voffB);
        PG8_WAIT_V(6); PG8_BAR;
    }
    for (;;) {
        const bool has_next = S.next(ui + 1, nxt);
        const char* nA = has_next ? (const char*)g.A + nxt.aoff : cA; const char* nB = has_next ? (const char*)g.Bt + nxt.boff : cB;
        if constexpr (GATHER) { if (has_next) PG8_GOFF(nxt, voffAn, voffA1n); else {
#pragma unroll
            for (int i = 0; i < 2; ++i) { voffAn[i] = voffA[i]; voffA1n[i] = voffA1[i]; } } }
#pragma nounroll
        for (int t = 0; t < nt; t += 2) {
            const bool last = (t == nt - 2);
            const char* a1 = cA + (size_t)(t + 1) * ksA;
            const char* a2 = last ? nA : cA + (size_t)(t + 2) * ksA; const char* b2 = last ? nB : cB + (size_t)(t + 2) * ksB;
            const char* a3 = a2 + ksA; const char* b3 = b2 + ksB;
            unsigned vx[2], vx1[2];
#pragma unroll
            for (int i = 0; i < 2; ++i) { vx[i] = (GATHER && last) ? voffAn[i] : voffA[i]; vx1[i] = (GATHER && last) ? voffA1n[i] : voffA1[i]; }
            PG8_LDB(B0, 0, 0); PG8_LDB(B1, 0, 1); PG8_SCHED; PG8_LDA(At, 0, 0); PG8_STAGE(PG8_SA(1, 1), a1, voffA1);
            PG8_WAIT_V(8); PG8_WAIT_L(0); PG8_BAR; PG8_MMA(0, 0, At, B0); PG8_MMA(0, 1, At, B1); PG8_BAR; PG8_SCHED;
            PG8_LDA(At, 0, 1); PG8_STAGE(PG8_SB(0, 0), b2, voffB); PG8_STAGE(PG8_SB(0, 1), b2 + hsB, voffB); PG8_STAGE(PG8_SA(0, 0), a2, vx);
            PG8_WAIT_V(8); PG8_WAIT_L(0); PG8_BAR; PG8_MMA(1, 0, At, B0); PG8_MMA(1, 1, At, B1); PG8_BAR; PG8_SCHED;
            PG8_LDB(B0, 1, 0); PG8_LDB(B1, 1, 1); PG8_SCHED; PG8_LDA(At, 1, 0); PG8_STAGE(PG8_SA(0, 1), a2, vx1);
            PG8_WAIT_V(8); PG8_WAIT_L(0); PG8_BAR; PG8_MMA(0, 0, At, B0); PG8_MMA(0, 1, At, B1); PG8_BAR; PG8_SCHED;
            PG8_LDA(At, 1, 1); PG8_STAGE(PG8_SB(1, 0), b3, voffB); PG8_STAGE(PG8_SB(1, 1), b3 + hsB, voffB); PG8_STAGE(PG8_SA(1, 0), a3, vx);
            PG8_WAIT_V(8); PG8_WAIT_L(0); PG8_BAR; PG8_MMA(1, 0, At, B0); PG8_MMA(1, 1, At, B1); PG8_BAR; PG8_SCHED;
        }
        if constexpr (ALIGN_EPI) { if (wr == 0) PG8_BAR; }
        E(acc, cur, wr, wc, fr, fq);
        if (!has_next) break;
#pragma unroll
        for (int a = 0; a < 2; ++a)
#pragma unroll
            for (int b = 0; b < 2; ++b)
#pragma unroll
                for (int m = 0; m < 4; ++m)
#pragma unroll
                    for (int n = 0; n < 2; ++n) acc[a][b][m][n] = (f32x4){0.f, 0.f, 0.f, 0.f};
        cur = nxt; cA = nA; cB = nB; ++ui;
        if constexpr (GATHER) {
#pragma unroll
            for (int i = 0; i < 2; ++i) { voffA[i] = voffAn[i]; voffA1[i] = voffA1n[i]; } }
        if constexpr (ALIGN_EPI) { if (wr == 1) PG8_BAR; }
    }
    PG8_WAIT_V(0);
    if constexpr (!ALIGN_EPI) { if (wr == 0) PG8_BAR; }
    PG8_BAR;
#undef PG8_GOFF
#undef PG8_SA
#undef PG8_SB
#undef PG8_STAGE
#undef PG8_LDA
#undef PG8_LDB
#undef PG8_MMA
#undef PG8_WAIT_V
#undef PG8_WAIT_L
#undef PG8_BAR
#undef PG8_SCHED
}
}
using pg8::Unit;

struct EpiProj {
    static constexpr bool PERM = true;
    bf16* O; float* ssq;
    __device__ __forceinline__ void operator()(const f32x4 (&acc)[2][2][4][2], const Unit& u, int wr, int wc, int fr, int fq) const {
        const int row0 = u.pm * 256 + wr * 64 + fr, col0 = u.pn * 256 + wc * 32 + 8 * fq;
#pragma unroll
        for (int ai = 0; ai < 2; ++ai)
#pragma unroll
            for (int m = 0; m < 4; ++m) {
                const int row = row0 + ai * 128 + m * 16;
                bf16* rowp = O + (size_t)row * PJ + col0;
#pragma unroll
                for (int bj = 0; bj < 2; ++bj) {
                    const f32x4 v0 = acc[ai][bj][m][0], v1 = acc[ai][bj][m][1];
                    v4u w; w.x = pg8::cvt_pk_bf16(v0[0], v0[1]); w.y = pg8::cvt_pk_bf16(v0[2], v0[3]); w.z = pg8::cvt_pk_bf16(v1[0], v1[1]); w.w = pg8::cvt_pk_bf16(v1[2], v1[3]);
                    *(v4u*)(rowp + bj * 128) = w;
                    if (u.pn < 3) {
                        float s = (v0[0] * v0[0] + v0[1] * v0[1]) + (v0[2] * v0[2] + v0[3] * v0[3]) + (v1[0] * v1[0] + v1[1] * v1[1]) + (v1[2] * v1[2] + v1[3] * v1[3]);
                        s += __shfl_xor(s, 16); s += __shfl_xor(s, 32);
                        if (fq == 0) ssq[(size_t)row * 24 + u.pn * 8 + bj * 4 + wc] = s;
                    }
                }
            }
    }
};


struct EpiQ {
    static constexpr bool PERM = true;
    bf16* Q; const LAS float* rs; const float* ropec; const float* ropes;
    __device__ __forceinline__ void operator()(const f32x4 (&acc)[2][2][4][2], const Unit& u, int wr, int wc, int fr, int fq) const {
        const int rl0 = wr * 64 + fr, row0 = u.pm * 256 + rl0;
        int head[2], d0[2];
#pragma unroll
        for (int bj = 0; bj < 2; ++bj) { const int g0 = u.pn * 256 + bj * 128 + wc * 32 + 8 * fq; head[bj] = g0 / 96; d0[bj] = g0 - head[bj] * 96; }
#pragma unroll
        for (int ai = 0; ai < 2; ++ai)
#pragma unroll
            for (int m = 0; m < 4; ++m) {
                const int row = row0 + ai * 128 + m * 16;
                const float sc = rs[u.aux * 256 + rl0 + ai * 128 + m * 16] * QSCALE;
                const int t = row % 2064;
#pragma unroll
                for (int bj = 0; bj < 2; ++bj) {
                    const f32x4 v0 = acc[ai][bj][m][0] * sc, v1 = acc[ai][bj][m][1] * sc;
                    bf16* dst = Q + (size_t)row * 768 + head[bj] * 96;
                    if (d0[bj] < 64) {
                        v4u w; w.x = pg8::cvt_pk_bf16(v0[0], v0[1]); w.y = pg8::cvt_pk_bf16(v0[2], v0[3]); w.z = pg8::cvt_pk_bf16(v1[0], v1[1]); w.w = pg8::cvt_pk_bf16(v1[2], v1[3]);
                        *(v4u*)(dst + d0[bj]) = w;
                    } else {
                        const int i4 = (d0[bj] - 64) >> 1;
                        const f32x4 c = *(const f32x4*)(ropec + t * 16 + i4), sn = *(const f32x4*)(ropes + t * 16 + i4);
                        const f32x4 o1 = v0 * c - v1 * sn, o2 = v1 * c + v0 * sn;
                        v2u w1; w1.x = pg8::cvt_pk_bf16(o1[0], o1[1]); w1.y = pg8::cvt_pk_bf16(o1[2], o1[3]);
                        v2u w2; w2.x = pg8::cvt_pk_bf16(o2[0], o2[1]); w2.y = pg8::cvt_pk_bf16(o2[2], o2[3]);
                        *(v2u*)(dst + 64 + i4) = w1; *(v2u*)(dst + 80 + i4) = w2;
                    }
                }
                asm volatile("" ::: "memory");
            }
    }
};
struct EpiKV {
    static constexpr bool PERM = true;
    bf16* Kb; bf16* Vb; const LAS float* rs;
    __device__ __forceinline__ void operator()(const f32x4 (&acc)[2][2][4][2], const Unit& u, int wr, int wc, int fr, int fq) const {
        const int rl0 = wr * 64 + fr, row0 = u.pm * 256 + rl0;
#pragma unroll
        for (int ai = 0; ai < 2; ++ai)
#pragma unroll
            for (int m = 0; m < 4; ++m) {
                const int row = row0 + ai * 128 + m * 16;
                const float sc = rs[u.aux * 256 + rl0 + ai * 128 + m * 16];
#pragma unroll
                for (int bj = 0; bj < 2; ++bj) {
                    const int g0 = u.pn * 256 + bj * 128 + wc * 32 + 8 * fq;
                    const int h = g0 >> 7, dd = g0 & 127;
                    const f32x4 v0 = acc[ai][bj][m][0] * sc, v1 = acc[ai][bj][m][1] * sc;
                    v4u w; w.x = pg8::cvt_pk_bf16(v0[0], v0[1]); w.y = pg8::cvt_pk_bf16(v0[2], v0[3]); w.z = pg8::cvt_pk_bf16(v1[0], v1[1]); w.w = pg8::cvt_pk_bf16(v1[2], v1[3]);
                    bf16* dst = dd < 64 ? Kb + (size_t)row * 768 + h * 96 + dd : Vb + (size_t)row * 512 + h * 64 + (dd - 64);
                    *(v4u*)dst = w;
                }
                asm volatile("" ::: "memory");
            }
    }
};

struct Args {
    const float* in[23];
    float* out; unsigned char* ws;
    int ph_lo, ph_hi; int never; int pad;
};
struct Frame {
    LAS unsigned char* lds;
    int tid, lane, wave, G, bid;
    unsigned char* ws;
};

__device__ __forceinline__ float wave_sum_x(float v) {
#pragma unroll
    for (int o = 1; o < 64; o <<= 1) v += __shfl_xor(v, o);
    return v;
}

__device__ __forceinline__ void transpose_item(const float* W, int K, int N, bf16* WT, int k0, int n0, int drow0, bool rope_perm, const float* gain, LAS float* scr, int lane) {
#pragma unroll 8
    for (int i = 0; i < 32; ++i) { const int kk = 2 * i + (lane >> 5); float v = W[(size_t)(k0 + kk) * N + n0 + (lane & 31)]; if (gain) v *= gain[k0 + kk]; scr[kk * 33 + (lane & 31)] = v; }
    LDS_WAIT(); asm volatile("" ::: "memory");
    const int c = lane & 7;
#pragma unroll
    for (int j = 0; j < 4; ++j) { const int n = (lane >> 3) + 8 * j; const LAS float* s = scr + (8 * c) * 33 + n;
        v4u o; o.x = pk2(s[0 * 33], s[1 * 33]); o.y = pk2(s[2 * 33], s[3 * 33]); o.z = pk2(s[4 * 33], s[5 * 33]); o.w = pk2(s[6 * 33], s[7 * 33]);
        int dn = n;
        if (rope_perm) { const int o16 = n & 15, hi = n >> 4; dn = 8 * (o16 >> 2) + 4 * hi + (o16 & 3); }
        *(GAS v4u*)(WT + (size_t)(drow0 + dn) * K + k0 + 8 * c) = o; }
    LDS_WAIT(); asm volatile("" ::: "memory");
}

__device__ __forceinline__ void conv_weights_a(Frame& F, const Args& a) {
    LAS float* scr = (LAS float*)(F.lds + F.wave * 16384);
    const int gw = F.bid * NWAVES + F.wave, NGW = F.G * NWAVES;
    const float* w_in = a.in[3]; const float* q_norm = a.in[4]; const float* w_uq = a.in[5]; const float* kv_norm = a.in[6]; const float* w_ukv = a.in[7];
    const float* w_brm = a.in[10]; const float* w_brh = a.in[11]; const float* w_out = a.in[13]; const float* w1 = a.in[19]; const float* w3 = a.in[20];
    bf16* WIN = (bf16*)(a.ws + WS_WIN); bf16* WUQ = (bf16*)(a.ws + WS_WUQ); bf16* WUKV = (bf16*)(a.ws + WS_WUKV);
    bf16* WBRM = (bf16*)(a.ws + WS_WBRM); bf16* WBRH = (bf16*)(a.ws + WS_WBRH); bf16* WOUT = (bf16*)(a.ws + WS_WOUT);
    bf16* W13 = (bf16*)a.out;
    constexpr int I_IN = 16 * 149, I_UQ = 6 * 24, I_UKV = 4 * 32, I_BR = 8 * 32, I_OUT = 16 * 32, I_E13 = 16 * 8;
    constexpr int NITEMS = I_IN + I_UQ + I_UKV + 2 * I_BR + I_OUT + 64 * 2 * I_E13;
    for (int it = gw; it < NITEMS; it += NGW) {
        int r = it;
        if (r < I_IN) { const int kb = r / 149, nb = r % 149, n0 = nb * 32; transpose_item(w_in, 1024, 4768, WIN, kb * 64, n0, n0 < 672 ? n0 : n0 + 96, false, nullptr, scr, F.lane); continue; } r -= I_IN;
        if (r < I_UQ) { const int kb = r / 24, nb = r % 24, n0 = nb * 32; transpose_item(w_uq, 384, 768, WUQ, kb * 64, n0, n0, (nb % 3) == 2, q_norm, scr, F.lane); continue; } r -= I_UQ;
        if (r < I_UKV) { const int kb = r / 32, nb = r % 32; transpose_item(w_ukv, 256, 1024, WUKV, kb * 64, nb * 32, nb * 32, false, kv_norm, scr, F.lane); continue; } r -= I_UKV;
        if (r < I_BR) { const int kb = r / 32, nb = r % 32; transpose_item(w_brm, 512, 1024, WBRM, kb * 64, nb * 32, nb * 32, false, nullptr, scr, F.lane); continue; } r -= I_BR;
        if (r < I_BR) { const int kb = r / 32, nb = r % 32; transpose_item(w_brh, 512, 1024, WBRH, kb * 64, nb * 32, nb * 32, false, nullptr, scr, F.lane); continue; } r -= I_BR;
        if (r < I_OUT) { const int kb = r / 32, nb = r % 32; transpose_item(w_out, 1024, 1024, WOUT, kb * 64, nb * 32, nb * 32, false, nullptr, scr, F.lane); continue; } r -= I_OUT;
        { const int e = r / (2 * I_E13), q = r % (2 * I_E13), which = q / I_E13, i2 = q % I_E13, kb = i2 / 8, nb = i2 % 8;
          const float* src = (which ? w3 : w1) + (size_t)e * 1024 * 256;
          transpose_item(src, 1024, 256, W13 + (size_t)e * 512 * 1024, kb * 64, nb * 32, (nb >> 2) * 256 + which * 128 + (nb & 3) * 32, false, nullptr, scr, F.lane); }
    }
    for (int i = F.bid * NTHR + F.tid; i < 96 * 1024 / 8; i += F.G * NTHR) ((GAS v4u*)(WIN + (size_t)672 * 1024))[i] = (v4u){0u, 0u, 0u, 0u};
}

__device__ __forceinline__ const float* h0row_n(const float* x, const float* meta, int n) {
    const int b = n / 2064, t = n - b * 2064;
    return t < 16 ? meta + (size_t)t * 1024 : x + ((size_t)b * 2048 + (t - 16)) * 1024;
}

__device__ __forceinline__ void phase0(Frame& F, const Args& a) {
    conv_weights_a(F, a);
    float* ropec = (float*)(a.ws + WS_ROPE); float* ropes = ropec + 2064 * 16;
    for (int i = F.bid * NTHR + F.tid; i < 2064 * 16; i += F.G * NTHR) {
        const int j = i & 15, t = i >> 4;
        const float inv = powf(10000.0f, -(float)(2 * j) / 32.0f);
        const float ang = (float)t * inv;
        ropec[i] = cosf(ang); ropes[i] = sinf(ang);
    }
    { float* WRT = (float*)(a.ws + WS_WRT); const float* fn = a.in[14]; const float* wgp = a.in[15]; const float* wrt = a.in[17];
      for (int i = F.bid * NTHR + F.tid; i < 80 * 1024; i += F.G * NTHR) { const int n = i >> 10, kx = i & 1023;
          WRT[i] = n < 8 ? fn[kx] * wgp[kx * 8 + n] : (n < 72 ? fn[kx] * wrt[kx * 64 + (n - 8)] : 0.f); } }
    const float* x = a.in[0]; const float* meta = a.in[1]; const float* g = a.in[2];
    bf16* U = (bf16*)(a.ws + WS_B);
    const int gw = F.bid * NWAVES + F.wave, NGW = F.G * NWAVES;
    f32x4 gv[4];
#pragma unroll
    for (int j = 0; j < 4; ++j) gv[j] = ((const f32x4*)g)[F.lane + 64 * j];
    for (int n = gw; n < MP; n += NGW) {
        unsigned long long* o8 = (unsigned long long*)(U + (size_t)n * 1024) + F.lane;
        if (n >= 16512) {
#pragma unroll
            for (int j = 0; j < 4; ++j) o8[64 * j] = 0ull;
            continue;
        }
        const f32x4* xr = (const f32x4*)h0row_n(x, meta, n) + F.lane;
        f32x4 v[4]; float s = 0.f;
#pragma unroll
        for (int j = 0; j < 4; ++j) { v[j] = xr[64 * j]; s += (v[j][0] * v[j][0] + v[j][1] * v[j][1]) + (v[j][2] * v[j][2] + v[j][3] * v[j][3]); }
        const float rs = rsqrtf(wave_sum_x(s) * (1.0f / 1024.0f) + 1e-6f);
#pragma unroll
        for (int j = 0; j < 4; ++j) { const f32x4 y = v[j] * rs * gv[j]; o8[64 * j] = (unsigned long long)pk2(y[0], y[1]) | ((unsigned long long)pk2(y[2], y[3]) << 32); }
    }
}

__device__ __forceinline__ void phase1(Frame& F, const Args& a) {
    pg8::Gemm g{(const bf16*)(a.ws + WS_B), (const bf16*)(a.ws + WS_WIN), 1024, 64, 1024, nullptr};
    pg8::DenseOrder S; S.init(MP / 256, PJ / 256, F.G, F.bid, 1024, 1024);
    EpiProj E{(bf16*)(a.ws + WS_C), (float*)(a.ws + WS_SSQ)};
    pg8::gemm_phase<EpiProj, pg8::DenseOrder>(F.lds, g, S, E);
}


__device__ __forceinline__ void phase2_mla(Frame& F, const Args& a) {
    const bf16* PROJ = (const bf16*)(a.ws + WS_C);
    const float* ssq = (const float*)(a.ws + WS_SSQ);
    const float* ropec = (const float*)(a.ws + WS_ROPE); const float* ropes = ropec + 2064 * 16;
    bf16* Qb = (bf16*)(a.ws + WS_Q); bf16* Kb = (bf16*)(a.ws + WS_K); bf16* Vb = (bf16*)(a.ws + WS_V);
    {
        pg8::Gemm g{PROJ, (const bf16*)(a.ws + WS_WUQ), PJ, 64, 384, nullptr};
        pg8::DenseOrder S; S.init(MP / 256, 3, F.G, F.bid, PJ, 384);
        LAS float* rs = (LAS float*)(F.lds + LDSX_OFF);
        for (int i = 0; i < 2; ++i) { Unit u; if (S.next(i, u) && F.tid < 256) {
            const f32x4* sp = (const f32x4*)(ssq + (size_t)(u.pm * 256 + F.tid) * 24); const f32x4 s0 = sp[0], s1 = sp[1], s2 = sp[2];
            const float ss = ((s0[0] + s0[1]) + (s0[2] + s0[3])) + ((s1[0] + s1[1]) + (s1[2] + s1[3])) + ((s2[0] + s2[1]) + (s2[2] + s2[3]));
            rs[i * 256 + F.tid] = rsqrtf(ss * (1.0f / 384.0f) + 1e-6f); } }
        __syncthreads();
        EpiQ E{Qb, rs, ropec, ropes};
        pg8::gemm_phase<EpiQ, pg8::DenseOrder>(F.lds, g, S, E);
    }
    {
        pg8::Gemm g{PROJ + 384, (const bf16*)(a.ws + WS_WUKV), PJ, 64, 256, nullptr};
        pg8::DenseOrder S; S.init(MP / 256, 4, F.G, (F.bid + 128) % F.G, PJ, 256);
        LAS float* rs = (LAS float*)(F.lds + LDSX_OFF + 2048);
        for (int i = 0; i < 2; ++i) { Unit u; if (S.next(i, u) && F.tid < 256) {
            const f32x4* sp = (const f32x4*)(ssq + (size_t)(u.pm * 256 + F.tid) * 24 + 12); const f32x4 s0 = sp[0], s1 = sp[1];
            const float ss = ((s0[0] + s0[1]) + (s0[2] + s0[3])) + ((s1[0] + s1[1]) + (s1[2] + s1[3]));
            rs[i * 256 + F.tid] = rsqrtf(ss * (1.0f / 256.0f) + 1e-6f); } }
        __syncthreads();
        EpiKV E{Kb, Vb, rs};
        pg8::gemm_phase<EpiKV, pg8::DenseOrder>(F.lds, g, S, E);
    }
    for (int i = F.bid * NTHR + F.tid; i < 16512 * 8; i += F.G * NTHR) {
        const int n = i >> 3, h = i & 7, t = n % 2064;
        const v4u* src = (const v4u*)(PROJ + (size_t)n * PJ + 640);
        const v4u a0 = src[0], a1 = src[1], b0 = src[2], b1 = src[3];
        const f32x4* cp = (const f32x4*)(ropec + t * 16); const f32x4* sp = (const f32x4*)(ropes + t * 16);
        unsigned x1w[8] = {a0.x, a0.y, a0.z, a0.w, a1.x, a1.y, a1.z, a1.w}, x2w[8] = {b0.x, b0.y, b0.z, b0.w, b1.x, b1.y, b1.z, b1.w};
        unsigned o1[8], o2[8];
#pragma unroll
        for (int q = 0; q < 4; ++q) {
            const f32x4 c = cp[q], sn = sp[q];
#pragma unroll
            for (int e = 0; e < 2; ++e) {
                const float x1l = bflo(x1w[2 * q + e]), x1h = bfhi(x1w[2 * q + e]), x2l = bflo(x2w[2 * q + e]), x2h = bfhi(x2w[2 * q + e]);
                const float cl = c[2 * e], ch = c[2 * e + 1], sl = sn[2 * e], sh = sn[2 * e + 1];
                o1[2 * q + e] = pk2(x1l * cl - x2l * sl, x1h * ch - x2h * sh);
                o2[2 * q + e] = pk2(x2l * cl + x1l * sl, x2h * ch + x1h * sh);
            }
        }
        v4u* dst = (v4u*)(Kb + (size_t)n * 768 + h * 96 + 64);
        dst[0] = (v4u){o1[0], o1[1], o1[2], o1[3]}; dst[1] = (v4u){o1[4], o1[5], o1[6], o1[7]};
        dst[2] = (v4u){o2[0], o2[1], o2[2], o2[3]}; dst[3] = (v4u){o2[4], o2[5], o2[6], o2[7]};
    }
}

typedef float f32x16 __attribute__((ext_vector_type(16)));
typedef short s16x4 __attribute__((ext_vector_type(4)));
typedef short v4i16_t __attribute__((ext_vector_type(4)));
constexpr int AT_KSLOT = 12288, AT_VSLOT = 8192, AT_BUF = AT_KSLOT + AT_VSLOT;
__device__ __forceinline__ unsigned cvtpk(float lo, float hi) { typedef float f2 __attribute__((ext_vector_type(2))); typedef __bf16 b2 __attribute__((ext_vector_type(2))); f2 v = {lo, hi}; b2 b = __builtin_convertvector(v, b2); return __builtin_bit_cast(unsigned, b); }
__device__ __forceinline__ s16x4 vtr(const LAS unsigned char* p) { return __builtin_bit_cast(s16x4, __builtin_amdgcn_ds_read_tr16_b64_v4i16((LAS v4i16_t*)p)); }

__device__ __forceinline__ void attn_unit(Frame& F, const bf16* Kb, const bf16* Vb, bf16* Qb, int b, int h, int j) {
    const int lane = F.lane, r32 = lane & 31, hi = lane >> 5, wid = F.wave;
    const int qstart = 16 + 256 * j, qlo = qstart + 32 * wid, tq = qlo + r32;
    const size_t nb = (size_t)b * 2064;
    const int NT = 4 * j + 5;
    const bf16* ksrc0 = Kb + (nb + lane) * 768 + h * 96 + wid * 8;
    const bf16* ksrc1 = ksrc0 + 64;
    const bf16* vsrc = Vb + (nb + 16 * (wid & 3) + (lane >> 2)) * 512 + h * 64 + (wid >> 2) * 32 + (lane & 3) * 8;
#define AT_ISSUE(t, bufo) do { \
        __builtin_amdgcn_global_load_lds((const unsigned*)(ksrc0 + (size_t)(t) * 64 * 768), (LAS unsigned*)(F.lds + (bufo) + wid * 1024), 16, 0, 0); \
        if (wid < 4) __builtin_amdgcn_global_load_lds((const unsigned*)(ksrc1 + (size_t)(t) * 64 * 768), (LAS unsigned*)(F.lds + (bufo) + (8 + wid) * 1024), 16, 0, 0); \
        __builtin_amdgcn_global_load_lds((const unsigned*)(vsrc + (size_t)(t) * 64 * 512), (LAS unsigned*)(F.lds + (bufo) + AT_KSLOT + wid * 1024), 16, 0, 0); } while (0)
    AT_ISSUE(0, 0);
    bf16x8 qr[6];
    { const bf16* qp = Qb + (nb + tq) * 768 + h * 96 + hi * 8;
#pragma unroll
      for (int d0 = 0; d0 < 6; ++d0) qr[d0] = *(const bf16x8*)(qp + 16 * d0); }
    f32x16 o0, o1;
#pragma unroll
    for (int r = 0; r < 16; ++r) { o0[r] = 0.f; o1[r] = 0.f; }
    float mrow = -INFINITY, lrow = 0.f;
    const int kvoff = ((lane >> 4) & 1) * 32 + (lane & 3) * 8 + (4 * hi + ((lane & 15) >> 2)) * 64;
    for (int i = 0; i < NT; ++i) {
        const int bufo = (i & 1) * AT_BUF;
        asm volatile("s_waitcnt vmcnt(0)" ::: "memory");
        __syncthreads();
        if (i + 1 < NT) AT_ISSUE(i + 1, ((i + 1) & 1) * AT_BUF);
        if (64 * i <= qlo + 31) {
            const LAS unsigned char* kp = F.lds + bufo + hi * 1024 + r32 * 16;
            f32x16 p0, p1;
#pragma unroll
            for (int r = 0; r < 16; ++r) { p0[r] = 0.f; p1[r] = 0.f; }
#pragma unroll
            for (int d0 = 0; d0 < 6; ++d0) {
                const bf16x8 k0 = *(const LAS bf16x8*)(kp + d0 * 2048), k1 = *(const LAS bf16x8*)(kp + d0 * 2048 + 512);
                p0 = __builtin_amdgcn_mfma_f32_32x32x16_bf16(k0, qr[d0], p0, 0, 0, 0);
                p1 = __builtin_amdgcn_mfma_f32_32x32x16_bf16(k1, qr[d0], p1, 0, 0, 0);
            }
            if (64 * i + 63 > qlo) {
                const int kb = 64 * i + 4 * hi;
#pragma unroll
                for (int r = 0; r < 16; ++r) { const int kv = kb + (r & 3) + 8 * (r >> 2); if (kv > tq) p0[r] = -INFINITY; if (kv + 32 > tq) p1[r] = -INFINITY; }
            }
            float rm = fmaxf(p0[0], p1[0]);
#pragma unroll
            for (int r = 1; r < 16; ++r) rm = fmaxf(rm, fmaxf(p0[r], p1[r]));
            { auto rr = __builtin_amdgcn_permlane32_swap(__float_as_uint(rm), __float_as_uint(rm), false, false); rm = fmaxf(__uint_as_float(rr[0]), __uint_as_float(rr[1])); }
            const float mnew = fmaxf(mrow, rm);
            const float alpha = __builtin_amdgcn_exp2f(mrow - mnew);
            mrow = mnew;
            float rsum = 0.f;
#pragma unroll
            for (int r = 0; r < 16; ++r) { p0[r] = __builtin_amdgcn_exp2f(p0[r] - mnew); p1[r] = __builtin_amdgcn_exp2f(p1[r] - mnew); rsum += p0[r] + p1[r]; }
            lrow = lrow * alpha + rsum;
#pragma unroll
            for (int r = 0; r < 16; ++r) { o0[r] *= alpha; o1[r] *= alpha; }
            v4u pw[4];
#pragma unroll
            for (int q = 0; q < 4; ++q) {
                pw[0][q] = cvtpk(p0[2 * q], p0[2 * q + 1]); pw[1][q] = cvtpk(p0[8 + 2 * q], p0[9 + 2 * q]);
                pw[2][q] = cvtpk(p1[2 * q], p1[2 * q + 1]); pw[3][q] = cvtpk(p1[8 + 2 * q], p1[9 + 2 * q]);
            }
            const LAS unsigned char* vp = F.lds + bufo + AT_KSLOT + kvoff;
#pragma unroll
            for (int ks = 0; ks < 4; ++ks) {
                const s16x4 a_lo = vtr(vp + ks * 1024), a_hi = vtr(vp + ks * 1024 + 512);
                const s16x4 b_lo = vtr(vp + 4096 + ks * 1024), b_hi = vtr(vp + 4096 + ks * 1024 + 512);
                const bf16x8 va = (bf16x8){a_lo[0], a_lo[1], a_lo[2], a_lo[3], a_hi[0], a_hi[1], a_hi[2], a_hi[3]};
                const bf16x8 vb = (bf16x8){b_lo[0], b_lo[1], b_lo[2], b_lo[3], b_hi[0], b_hi[1], b_hi[2], b_hi[3]};
                const bf16x8 pb = __builtin_bit_cast(bf16x8, pw[ks]);
                o0 = __builtin_amdgcn_mfma_f32_32x32x16_bf16(va, pb, o0, 0, 0, 0);
                o1 = __builtin_amdgcn_mfma_f32_32x32x16_bf16(vb, pb, o1, 0, 0, 0);
            }
        }
    }
#undef AT_ISSUE
    { auto rr = __builtin_amdgcn_permlane32_swap(__float_as_uint(lrow), __float_as_uint(lrow), false, false); lrow = __uint_as_float(rr[0]) + __uint_as_float(rr[1]); }
    const float inv = 1.0f / lrow;
    bf16* op = Qb + (nb + tq) * 768 + h * 96 + 4 * hi;
#pragma unroll
    for (int g = 0; g < 4; ++g) {
        v2u w0; w0.x = cvtpk(o0[4 * g] * inv, o0[4 * g + 1] * inv); w0.y = cvtpk(o0[4 * g + 2] * inv, o0[4 * g + 3] * inv);
        v2u w1; w1.x = cvtpk(o1[4 * g] * inv, o1[4 * g + 1] * inv); w1.y = cvtpk(o1[4 * g + 2] * inv, o1[4 * g + 3] * inv);
        *(v2u*)(op + 8 * g) = w0; *(v2u*)(op + 32 + 8 * g) = w1;
    }
    __syncthreads();
}
__device__ __forceinline__ void phase3_attn(Frame& F, const Args& a) {
    const bf16* Kb = (const bf16*)(a.ws + WS_K); const bf16* Vb = (const bf16*)(a.ws + WS_V); bf16* Qb = (bf16*)(a.ws + WS_Q);
    const int vcu = (F.G % 8 == 0) ? (F.bid % 8) * (F.G / 8) + F.bid / 8 : F.bid;
    for (int p = vcu; p < 256; p += F.G) {
        const int bh = p >> 2, jj = p & 3;
        attn_unit(F, Kb, Vb, Qb, bh >> 3, bh & 7, 7 - jj);
        attn_unit(F, Kb, Vb, Qb, bh >> 3, bh & 7, jj);
    }
}

constexpr int HG_P = 288;
constexpr int HG_QD = 0, HG_QS = 18432, HG_KD = 36864, HG_KE = 55296, HG_V = 73728, HG_QX = 92160, HG_KX = 96768, HG_PS = 101376, HG_RS = 103424, HG_END = 104448;
static_assert(HG_END <= RING_BYTES, "hgrn lds");
__device__ __forceinline__ bf16x8 tr_frag(const LAS unsigned char* tile, int s0, int colblk, int lane) {
    const int g = lane >> 4, q = (lane & 15) >> 2, p = lane & 3;
    const LAS unsigned char* a = tile + (s0 + 4 * g + q) * HG_P + (16 * colblk + 4 * p) * 2;
    const s16x4 lo = vtr(a), hi = vtr(a + 16 * HG_P);
    return (bf16x8){lo[0], lo[1], lo[2], lo[3], hi[0], hi[1], hi[2], hi[3]};
}
__device__ __forceinline__ float sigm(float v) { return 1.0f / (1.0f + __expf(-v)); }

template <int MODE>
__device__ __forceinline__ void hgrn_unit(Frame& F, const Args& a, int b, int h, int c) {
    const bf16* PROJ = (const bf16*)(a.ws + WS_C);
    const int tid = F.tid, lane = F.lane, wid = F.wave;
    const int I = tid >> 7, k = tid & 127, ch = h * 128 + k;
    const int t0 = (c == 0) ? -48 : 16 + 64 * (c - 1);
    const size_t nb = (size_t)b * 2064;
    LAS unsigned char* L = F.lds;
    LAS float* PS = (LAS float*)(L + HG_PS);
#pragma unroll
    for (int i = 0; i < 2; ++i) {
        const int id = tid + 512 * i, s = id >> 4, cc = id & 15, t = t0 + s;
        v4u v = (v4u){0u, 0u, 0u, 0u};
        if (t >= 0) v = *(const v4u*)(PROJ + (nb + t) * PJ + PJ_HI + h * 128 + cc * 8);
        *(LAS v4u*)(L + HG_V + s * HG_P + cc * 16) = v;
    }
    const float* lbt = a.in[8];
    const float lb = 1.0f / (1.0f + __expf(lbt[512 + ch] - lbt[ch]));
    float bl[16], kk[16], qq[16];
    float run = 0.f;
#pragma unroll
    for (int j = 0; j < 16; ++j) {
        const int t = t0 + 16 * I + j;
        float lf = 0.f, kv = 0.f, qv = 0.f;
        if (t >= 0) {
            const bf16* pr = PROJ + (nb + t) * PJ + ch;
            const float fr = bf2f(pr[PJ_HF]);
            const float f = lb + (1.0f - lb) * sigm(fr);
            lf = __logf(f); kv = 1.0f - f;
            if (MODE == 3) { const float qr = bf2f(pr[PJ_HQ]); qv = qr * sigm(qr); }
        }
        run += lf; bl[j] = run; kk[j] = kv; qq[j] = qv;
    }
    PS[I * 128 + k] = run;
    __syncthreads();
    const float P0 = PS[k], P1 = PS[128 + k], P2 = PS[256 + k], P3 = PS[384 + k];
    const float PI = I == 0 ? P0 : I == 1 ? P1 : I == 2 ? P2 : P3;
    const float BI = I == 0 ? 0.f : I == 1 ? P0 : I == 2 ? P0 + P1 : P0 + P1 + P2;
    if (MODE == 1) {
        const float bend = (P0 + P1) + (P2 + P3);
        const float tail = __expf(bend - (BI + PI));
        bf16* kt = (bf16*)0; (void)kt;
#pragma unroll
        for (int j = 0; j < 16; ++j) {
            const float ke = kk[j] * __expf(PI - bl[j]) * tail;
            *(LAS bf16*)(L + HG_KE + (16 * I + j) * HG_P + k * 2) = (bf16)f2bf(ke);
        }
        if (I == 0) ((float*)(a.ws + WS_DEC))[(size_t)((b * 4 + h) * 32 + c) * 128 + k] = __expf(bend);
    } else {
        const float eB = __expf(BI), eP2 = __expf(P2), eP1 = __expf(P1);
#pragma unroll
        for (int j = 0; j < 16; ++j) {
            const int p = 16 * I + j;
            const float e1 = __expf(bl[j]);
            const float qd = qq[j] * e1;
            *(LAS bf16*)(L + HG_QD + p * HG_P + k * 2) = (bf16)f2bf(qd);
            *(LAS bf16*)(L + HG_QS + p * HG_P + k * 2) = (bf16)f2bf(qd * eB);
            if (I == 3) *(LAS bf16*)(L + HG_QX + j * HG_P + k * 2) = (bf16)f2bf(qd * eP2);
            *(LAS bf16*)(L + HG_KD + p * HG_P + k * 2) = (bf16)f2bf(kk[j] * __expf(-bl[j]));
            const float ke = kk[j] * __expf(PI - bl[j]);
            if (I < 3) *(LAS bf16*)(L + HG_KE + p * HG_P + k * 2) = (bf16)f2bf(ke);
            if (I == 0) *(LAS bf16*)(L + HG_KX + j * HG_P + k * 2) = (bf16)f2bf(ke * eP1);
        }
    }
    __syncthreads();
    const int fr = lane & 15, fq = lane >> 4;
    if (MODE == 1) {
        bf16* ST = (bf16*)(a.ws + WS_B) + (size_t)((b * 4 + h) * 32 + c) * 16384;
        const bf16x8 ka0 = tr_frag(L + HG_KE, 0, wid, lane), ka1 = tr_frag(L + HG_KE, 32, wid, lane);
#pragma unroll
        for (int nt = 0; nt < 8; ++nt) {
            const bf16x8 vb0 = tr_frag(L + HG_V, 0, nt, lane), vb1 = tr_frag(L + HG_V, 32, nt, lane);
            f32x4 acc = (f32x4){0.f, 0.f, 0.f, 0.f};
            acc = __builtin_amdgcn_mfma_f32_16x16x32_bf16(ka0, vb0, acc, 0, 0, 0);
            acc = __builtin_amdgcn_mfma_f32_16x16x32_bf16(ka1, vb1, acc, 0, 0, 0);
            v2u w; w.x = cvtpk(acc[0], acc[1]); w.y = cvtpk(acc[2], acc[3]);
            *(v2u*)(ST + (size_t)(16 * nt + fr) * 128 + 16 * wid + 4 * fq) = w;
        }
    } else {
        const int I2 = wid >> 1, vh = wid & 1;
        const bf16* ST = (const bf16*)(a.ws + WS_B) + (size_t)((b * 4 + h) * 32 + (c - 1)) * 16384;
        f32x4 at[4];
#pragma unroll
        for (int J = 0; J < 4; ++J) {
            at[J] = (f32x4){0.f, 0.f, 0.f, 0.f};
            if (J <= I2) {
                const LAS unsigned char* kt = (J == I2) ? L + HG_KD + 16 * J * HG_P : ((J == 0 && I2 >= 2) ? L + HG_KX : L + HG_KE + 16 * J * HG_P);
                const LAS unsigned char* qt = (I2 == 3 && J <= 1) ? L + HG_QX : L + HG_QD + 16 * I2 * HG_P;
#pragma unroll
                for (int kc = 0; kc < 4; ++kc) {
                    const bf16x8 kf = *(const LAS bf16x8*)(kt + fr * HG_P + (32 * kc + 8 * fq) * 2);
                    const bf16x8 qf = *(const LAS bf16x8*)(qt + fr * HG_P + (32 * kc + 8 * fq) * 2);
                    at[J] = __builtin_amdgcn_mfma_f32_16x16x32_bf16(kf, qf, at[J], 0, 0, 0);
                }
                if (J == I2) {
#pragma unroll
                    for (int r = 0; r < 4; ++r) if (4 * fq + r > fr) at[J][r] = 0.f;
                }
            }
        }
        v4u aw0, aw1;
        aw0.x = cvtpk(at[0][0], at[0][1]); aw0.y = cvtpk(at[0][2], at[0][3]); aw0.z = cvtpk(at[1][0], at[1][1]); aw0.w = cvtpk(at[1][2], at[1][3]);
        aw1.x = cvtpk(at[2][0], at[2][1]); aw1.y = cvtpk(at[2][2], at[2][3]); aw1.z = cvtpk(at[3][0], at[3][1]); aw1.w = cvtpk(at[3][2], at[3][3]);
        const bf16x8 af0 = __builtin_bit_cast(bf16x8, aw0), af1 = __builtin_bit_cast(bf16x8, aw1);
        bf16x8 qs[4];
#pragma unroll
        for (int kc = 0; kc < 4; ++kc) qs[kc] = *(const LAS bf16x8*)(L + HG_QS + (16 * I2 + fr) * HG_P + (32 * kc + 8 * fq) * 2);
        f32x4 o[4]; float ssq[4] = {0.f, 0.f, 0.f, 0.f};
#pragma unroll
        for (int nt = 0; nt < 4; ++nt) {
            const int vt = 4 * vh + nt;
            f32x4 acc = (f32x4){0.f, 0.f, 0.f, 0.f};
#pragma unroll
            for (int kc = 0; kc < 4; ++kc) {
                const bf16x8 sf = *(const bf16x8*)(ST + (size_t)(16 * vt + fr) * 128 + 32 * kc + 8 * fq);
                acc = __builtin_amdgcn_mfma_f32_16x16x32_bf16(qs[kc], sf, acc, 0, 0, 0);
            }
            acc = __builtin_amdgcn_mfma_f32_16x16x32_bf16(af0, tr_frag(L + HG_V, 0, vt, lane), acc, 0, 0, 0);
            if (I2 >= 2) acc = __builtin_amdgcn_mfma_f32_16x16x32_bf16(af1, tr_frag(L + HG_V, 32, vt, lane), acc, 0, 0, 0);
            o[nt] = acc;
#pragma unroll
            for (int r = 0; r < 4; ++r) ssq[r] += acc[r] * acc[r];
        }
        LAS float* RS = (LAS float*)(L + HG_RS);
#pragma unroll
        for (int r = 0; r < 4; ++r) {
            float v = ssq[r];
            v += __shfl_xor(v, 1); v += __shfl_xor(v, 2); v += __shfl_xor(v, 4); v += __shfl_xor(v, 8);
            if (fr == 0) RS[vh * 64 + 16 * I2 + 4 * fq + r] = v;
        }
        __syncthreads();
        const float* hgn = a.in[9];
        bf16* OHG = (bf16*)(a.ws + WS_V);
#pragma unroll
        for (int r = 0; r < 4; ++r) {
            const int p = 16 * I2 + 4 * fq + r;
            const float rs = rsqrtf((RS[p] + RS[64 + p]) * (1.0f / 128.0f) + 1e-6f);
            const size_t n = nb + t0 + p;
#pragma unroll
            for (int nt = 0; nt < 4; ++nt) {
                const int v = 16 * (4 * vh + nt) + fr;
                const float g = bf2f(PROJ[n * PJ + PJ_HG + h * 128 + v]);
                OHG[n * 512 + h * 128 + v] = (bf16)f2bf(o[nt][r] * rs * hgn[h * 128 + v] * (g * sigm(g)));
            }
        }
    }
    __syncthreads();
}

__device__ __forceinline__ void phase2_hgrn(Frame& F, const Args& a) {
    for (int u = F.bid; u < 32 * 32; u += F.G) { const int bh = u >> 5, c = u & 31; hgrn_unit<1>(F, a, bh >> 2, bh & 3, c); }
}
__device__ __forceinline__ void phase3_scan(Frame& F, const Args& a) {
    for (int gid = F.bid * NTHR + F.tid; gid < 32 * 128 * 32; gid += F.G * NTHR) {
        const int bh = gid >> 12, v = (gid >> 5) & 127, kq = gid & 31;
        v2u* st = (v2u*)((bf16*)(a.ws + WS_B) + (size_t)bh * 32 * 16384 + (size_t)v * 128 + 4 * kq);
        const f32x4* dec = (const f32x4*)((const float*)(a.ws + WS_DEC) + (size_t)bh * 32 * 128 + 4 * kq);
        f32x4 S = (f32x4){0.f, 0.f, 0.f, 0.f};
#pragma unroll 8
        for (int c = 0; c < 32; ++c) {
            const v2u w = st[(size_t)c * 4096];
            const f32x4 d = dec[c * 32];
            S[0] = d[0] * S[0] + bflo(w.x); S[1] = d[1] * S[1] + bfhi(w.x); S[2] = d[2] * S[2] + bflo(w.y); S[3] = d[3] * S[3] + bfhi(w.y);
            v2u o; o.x = cvtpk(S[0], S[1]); o.y = cvtpk(S[2], S[3]);
            st[(size_t)c * 4096] = o;
        }
    }
}
__device__ __forceinline__ void phase4_hgrn(Frame& F, const Args& a) {
    for (int u = F.bid; u < 32 * 32; u += F.G) { const int bh = u >> 5, c = 1 + (u & 31); hgrn_unit<3>(F, a, bh >> 2, bh & 3, c); }
}

constexpr size_t WS_MERGED = WS_B;
constexpr size_t WS_H1 = WS_C;
__device__ __forceinline__ int rown_of_tile(int pm) { return (pm >> 3) * 2064 + 16 + (pm & 7) * 256; }
struct TileOrder {
    int pm, pn; size_t aoff, boff;
    __device__ void init(int G, int bid, int lda, int K, bool padded_rows) {
        const int vcu = (G % 8 == 0) ? (bid % 8) * (G / 8) + bid / 8 : bid;
        pm = vcu >> 2; pn = vcu & 3;
        if (vcu >= 256) pm = -1;
        aoff = (size_t)(padded_rows ? rown_of_tile(pm) : pm * 256) * lda * 2; boff = (size_t)pn * 256 * K * 2;
    }
    __device__ bool next(int i, Unit& u) const { if (i > 0 || pm < 0) return false; u.pm = pm; u.pn = pn; u.aux = 0; u.rows = 256; u.lrow = 0; u.aoff = aoff; u.boff = boff; return true; }
};
template <int PASS> struct EpiGate {
    static constexpr bool PERM = true;
    const bf16* PROJ; const float* bgate; bf16* MG;
    __device__ __forceinline__ void operator()(const f32x4 (&acc)[2][2][4][2], const Unit& u, int wr, int wc, int fr, int fq) const {
        const int rl0 = wr * 64 + fr, col0 = u.pn * 256 + wc * 32 + 8 * fq;
        const int n0 = rown_of_tile(u.pm) + rl0, m0 = u.pm * 256 + rl0;
        f32x4 bv[2][2];
#pragma unroll
        for (int bj = 0; bj < 2; ++bj) { bv[bj][0] = *(const f32x4*)(bgate + PASS * 1024 + col0 + bj * 128); bv[bj][1] = *(const f32x4*)(bgate + PASS * 1024 + col0 + bj * 128 + 4); }
#pragma unroll
        for (int ai = 0; ai < 2; ++ai)
#pragma unroll
            for (int m = 0; m < 4; ++m) {
                const int ro = ai * 128 + m * 16;
                const bf16* gp = PROJ + (size_t)(n0 + ro) * PJ + (PASS == 0 ? PJ_GM : PJ_GH) + col0;
                bf16* mp = MG + (size_t)(m0 + ro) * 1024 + col0;
#pragma unroll
                for (int bj = 0; bj < 2; ++bj) {
                    const v4u gw = *(const v4u*)(gp + bj * 128);
                    const f32x4 a0 = acc[ai][bj][m][0], a1 = acc[ai][bj][m][1];
                    float r[8];
                    r[0] = a0[0] * sigm(bflo(gw.x) + bv[bj][0][0]); r[1] = a0[1] * sigm(bfhi(gw.x) + bv[bj][0][1]);
                    r[2] = a0[2] * sigm(bflo(gw.y) + bv[bj][0][2]); r[3] = a0[3] * sigm(bfhi(gw.y) + bv[bj][0][3]);
                    r[4] = a1[0] * sigm(bflo(gw.z) + bv[bj][1][0]); r[5] = a1[1] * sigm(bfhi(gw.z) + bv[bj][1][1]);
                    r[6] = a1[2] * sigm(bflo(gw.w) + bv[bj][1][2]); r[7] = a1[3] * sigm(bfhi(gw.w) + bv[bj][1][3]);
                    if (PASS == 1) {
                        const v4u pw = *(const v4u*)(mp + bj * 128);
                        r[0] += bflo(pw.x); r[1] += bfhi(pw.x); r[2] += bflo(pw.y); r[3] += bfhi(pw.y);
                        r[4] += bflo(pw.z); r[5] += bfhi(pw.z); r[6] += bflo(pw.w); r[7] += bfhi(pw.w);
                    }
                    v4u w; w.x = pg8::cvt_pk_bf16(r[0], r[1]); w.y = pg8::cvt_pk_bf16(r[2], r[3]); w.z = pg8::cvt_pk_bf16(r[4], r[5]); w.w = pg8::cvt_pk_bf16(r[6], r[7]);
                    *(v4u*)(mp + bj * 128) = w;
                }
                asm volatile("" ::: "memory");
            }
    }
};
struct EpiResid {
    static constexpr bool PERM = false;
    const float* X; float* H1;
    __device__ __forceinline__ void operator()(const f32x4 (&acc)[2][2][4][2], const Unit& u, int wr, int wc, int fr, int fq) const {
        const int m0 = u.pm * 256 + wr * 64 + fr, col0 = u.pn * 256 + wc * 32 + 4 * fq;
#pragma unroll
        for (int ai = 0; ai < 2; ++ai)
#pragma unroll
            for (int m = 0; m < 4; ++m) {
                const size_t off = (size_t)(m0 + ai * 128 + m * 16) * 1024 + col0;
#pragma unroll
                for (int bj = 0; bj < 2; ++bj)
#pragma unroll
                    for (int n = 0; n < 2; ++n) { const f32x4 xv = *(const f32x4*)(X + off + bj * 128 + n * 16); *(f32x4*)(H1 + off + bj * 128 + n * 16) = xv + acc[ai][bj][m][n]; }
                asm volatile("" ::: "memory");
            }
    }
};
__device__ __forceinline__ void phase5a(Frame& F, const Args& a) {
    const bf16* PROJ = (const bf16*)(a.ws + WS_C); bf16* MG = (bf16*)(a.ws + WS_MERGED);
    {   pg8::Gemm g{(const bf16*)(a.ws + WS_Q), (const bf16*)(a.ws + WS_WBRM), 768, 96, 512, nullptr};
        TileOrder S; S.init(F.G, F.bid, 768, 512, true);
        EpiGate<0> E{PROJ, a.in[12], MG};
        pg8::gemm_phase<EpiGate<0>, TileOrder>(F.lds, g, S, E); }
    {   pg8::Gemm g{(const bf16*)(a.ws + WS_V), (const bf16*)(a.ws + WS_WBRH), 512, 64, 512, nullptr};
        TileOrder S; S.init(F.G, F.bid, 512, 512, true);
        EpiGate<1> E{PROJ, a.in[12], MG};
        pg8::gemm_phase<EpiGate<1>, TileOrder>(F.lds, g, S, E); }
}
__device__ __forceinline__ void phase5b(Frame& F, const Args& a) {
    pg8::Gemm g{(const bf16*)(a.ws + WS_MERGED), (const bf16*)(a.ws + WS_WOUT), 1024, 64, 1024, nullptr};
    TileOrder S; S.init(F.G, F.bid, 1024, 1024, false);
    EpiResid E{a.in[0], (float*)(a.ws + WS_H1)};
    pg8::gemm_phase<EpiResid, TileOrder>(F.lds, g, S, E);
}

constexpr size_t WS_U2 = WS_B;
constexpr size_t WS_W2T = WS_C + 70 * MiB;
constexpr size_t WS_HDN = WS_C + 104 * MiB;
constexpr size_t WS_LIST = WS_C + 130 * MiB;
constexpr size_t WS_GATE = WS_C + 134 * MiB;
constexpr size_t WS_RSTD2 = WS_C + 135 * MiB;
constexpr size_t WS_Y = WS_D;
static_assert(WS_RSTD2 + MR * 4 <= WS_C + SZ_C && WS_HDN + (size_t)192 * 256 * 256 * 2 <= WS_LIST && WS_Y + (size_t)MR * 2048 * 2 <= WS_END, "late map");
constexpr int CW_CNT = 6000;

__device__ __forceinline__ void conv_w2(Frame& F, const Args& a) {
    LAS float* scr = (LAS float*)(F.lds + F.wave * 16384);
    const int gw = F.bid * NWAVES + F.wave, NGW = F.G * NWAVES;
    const float* w2 = a.in[21]; bf16* W2T = (bf16*)(a.ws + WS_W2T);
    for (int it = gw; it < 64 * 128; it += NGW) { const int e = it >> 7, r = it & 127, kb = r >> 5, nb = r & 31;
        transpose_item(w2 + (size_t)e * 256 * 1024, 256, 1024, W2T + (size_t)e * 1024 * 256, kb * 64, nb * 32, nb * 32, false, nullptr, scr, F.lane); }
}

__device__ __forceinline__ void phase5c(Frame& F, const Args& a) {
    conv_w2(F, a);
    __syncthreads();
    const float* H1 = (const float*)(a.ws + WS_H1); const float* WRT = (const float*)(a.ws + WS_WRT); const float* fn = a.in[14];
    bf16* U2 = (bf16*)(a.ws + WS_U2);
    const int lane = F.lane, wid = F.wave, tk = lane & 15, kq = lane >> 4;
    LAS float* XP = (LAS float*)(F.lds);
    LAS float* LG = (LAS float*)(F.lds + 32768);
    for (int mt0 = F.bid * 4; mt0 < MR / 16; mt0 += F.G * 4) {
        const int mt = mt0 + (wid & 3), kh = wid >> 2, m = mt * 16 + tk;
        f32x4 acc[5];
#pragma unroll
        for (int nt = 0; nt < 5; ++nt) acc[nt] = (f32x4){0.f, 0.f, 0.f, 0.f};
        float ss = 0.f;
        const float* hp = H1 + (size_t)m * 1024 + 512 * kh + 4 * kq;
        const float* wp = WRT + (size_t)tk * 1024 + 512 * kh + 4 * kq;
        bf16* up = U2 + (size_t)m * 1024 + 512 * kh + 4 * kq;
        const float* gp = fn + 512 * kh + 4 * kq;
#pragma unroll 2
        for (int j = 0; j < 32; ++j) {
            const f32x4 hv = *(const f32x4*)(hp + 16 * j);
            const f32x4 gv = *(const f32x4*)(gp + 16 * j);
            f32x4 wv[5];
#pragma unroll
            for (int nt = 0; nt < 5; ++nt) wv[nt] = *(const f32x4*)(wp + (size_t)nt * 16 * 1024 + 16 * j);
            ss += (hv[0] * hv[0] + hv[1] * hv[1]) + (hv[2] * hv[2] + hv[3] * hv[3]);
            v2u uw; uw.x = cvtpk(hv[0] * gv[0], hv[1] * gv[1]); uw.y = cvtpk(hv[2] * gv[2], hv[3] * gv[3]);
            *(v2u*)(up + 16 * j) = uw;
#pragma unroll
            for (int i = 0; i < 4; ++i)
#pragma unroll
                for (int nt = 0; nt < 5; ++nt) acc[nt] = __builtin_amdgcn_mfma_f32_16x16x4f32(hv[i], wv[nt][i], acc[nt], 0, 0, 0);
        }
        ss += __shfl_xor(ss, 16); ss += __shfl_xor(ss, 32);
        if (kh == 1) {
            LAS float* xp = XP + ((wid & 3) * 64 + lane) * 21;
#pragma unroll
            for (int nt = 0; nt < 5; ++nt)
#pragma unroll
                for (int r = 0; r < 4; ++r) xp[nt * 4 + r] = acc[nt][r];
            xp[20] = ss;
        }
        __syncthreads();
        if (kh == 0) {
            const LAS float* xp = XP + ((wid & 3) * 64 + lane) * 21;
#pragma unroll
            for (int nt = 0; nt < 5; ++nt)
#pragma unroll
                for (int r = 0; r < 4; ++r) acc[nt][r] += xp[nt * 4 + r];
            ss += xp[20];
            LAS float* lg = LG + (wid & 3) * 16 * 81;
#pragma unroll
            for (int nt = 0; nt < 5; ++nt)
#pragma unroll
                for (int r = 0; r < 4; ++r) lg[(4 * kq + r) * 81 + 16 * nt + tk] = acc[nt][r];
            asm volatile("s_waitcnt lgkmcnt(0)" ::: "memory");
            if (lane < 16) {
                const float rs = rsqrtf(ss * (1.0f / 1024.0f) + 1e-6f);
                const LAS float* tl = lg + lane * 81;
                const float* bg = a.in[16]; const float* br = a.in[18];
                float gl[8]; int gs = 0; float gm = -3.0e38f;
#pragma unroll
                for (int i = 0; i < 8; ++i) { gl[i] = tl[i] * rs + bg[i]; if (gl[i] > gm) { gm = gl[i]; gs = i; } }
                float den = 0.f;
#pragma unroll
                for (int i = 0; i < 8; ++i) den += __expf(gl[i] - gm);
                const float psel = 1.0f / den;
                int i0 = 0, i1 = 0; float v0 = -3.0e38f, v1 = -3.0e38f;
                for (int i = 0; i < 8; ++i) { const float e = tl[8 + gs * 8 + i] * rs + br[gs * 8 + i]; if (e > v0) { v1 = v0; i1 = i0; v0 = e; i0 = i; } else if (e > v1) { v1 = e; i1 = i; } }
                const float e1 = __expf(v1 - v0), w0 = 1.0f / (1.0f + e1), w1 = e1 / (1.0f + e1);
                const int mm = mt * 16 + lane;
                unsigned* cnt = (unsigned*)(a.ws + WS_CTL) + CW_CNT; int* LIST = (int*)(a.ws + WS_LIST); float* GATE = (float*)(a.ws + WS_GATE);
                const int ex0 = gs * 8 + i0, ex1 = gs * 8 + i1;
                const unsigned p0 = atomicAdd(&cnt[ex0], 1u), p1 = atomicAdd(&cnt[ex1], 1u);
                LIST[ex0 * 16384 + p0] = mm * 2; LIST[ex1 * 16384 + p1] = mm * 2 + 1;
                GATE[mm * 2] = psel * w0; GATE[mm * 2 + 1] = psel * w1;
                ((float*)(a.ws + WS_RSTD2))[mm] = rs;
            }
        }
        __syncthreads();
    }
}

struct MoeOrder {
    const LAS int* cnt; int G, bid, NC; size_t bstride, bcol;
    __device__ bool next(int i, Unit& u) const {
        const int L = i * G + bid, rt = L / NC, pn = L - rt * NC;
        int acc = 0;
        for (int e = 0; e < 64; ++e) { const int c = cnt[e], nt = (c + 255) >> 8;
            if (rt < acc + nt) { const int lt = rt - acc; u.pm = rt; u.pn = pn; u.aux = e; u.rows = min(256, c - 256 * lt); u.lrow = e * 16384 + 256 * lt;
                u.aoff = 0; u.boff = (size_t)e * bstride + (size_t)pn * bcol; return true; }
            acc += nt; }
        return false;
    }
};
struct EpiMoe1 {
    static constexpr bool PERM = true;
    bf16* HDN; const int* glist; const float* rstd;
    __device__ __forceinline__ void operator()(const f32x4 (&acc)[2][2][4][2], const Unit& u, int wr, int wc, int fr, int fq) const {
        const int rl0 = wr * 64 + fr;
#pragma unroll
        for (int ai = 0; ai < 2; ++ai)
#pragma unroll
            for (int m = 0; m < 4; ++m) {
                const int r = rl0 + ai * 128 + m * 16;
                if (r < u.rows) {
                    const float rs = rstd[glist[u.lrow + r] >> 1];
                    const f32x4 a0 = acc[ai][0][m][0] * rs, a1 = acc[ai][0][m][1] * rs, b0 = acc[ai][1][m][0] * rs, b1 = acc[ai][1][m][1] * rs;
                    float h[8];
#pragma unroll
                    for (int e = 0; e < 4; ++e) { h[e] = a0[e] * sigm(a0[e]) * b0[e]; h[4 + e] = a1[e] * sigm(a1[e]) * b1[e]; }
                    v4u w; w.x = pg8::cvt_pk_bf16(h[0], h[1]); w.y = pg8::cvt_pk_bf16(h[2], h[3]); w.z = pg8::cvt_pk_bf16(h[4], h[5]); w.w = pg8::cvt_pk_bf16(h[6], h[7]);
                    *(v4u*)(HDN + (size_t)(u.pm * 256 + r) * 256 + u.pn * 128 + wc * 32 + 8 * fq) = w;
                }
                asm volatile("" ::: "memory");
            }
    }
};
struct EpiMoe2 {
    static constexpr bool PERM = true;
    bf16* Y; const int* glist; const float* gate;
    __device__ __forceinline__ void operator()(const f32x4 (&acc)[2][2][4][2], const Unit& u, int wr, int wc, int fr, int fq) const {
        const int rl0 = wr * 64 + fr, col0 = u.pn * 256 + wc * 32 + 8 * fq;
#pragma unroll
        for (int ai = 0; ai < 2; ++ai)
#pragma unroll
            for (int m = 0; m < 4; ++m) {
                const int r = rl0 + ai * 128 + m * 16;
                if (r < u.rows) {
                    const int ts = glist[u.lrow + r]; const float gt = gate[ts];
                    bf16* yp = Y + (size_t)ts * 1024 + col0;
#pragma unroll
                    for (int bj = 0; bj < 2; ++bj) {
                        const f32x4 v0 = acc[ai][bj][m][0] * gt, v1 = acc[ai][bj][m][1] * gt;
                        v4u w; w.x = pg8::cvt_pk_bf16(v0[0], v0[1]); w.y = pg8::cvt_pk_bf16(v0[2], v0[3]); w.z = pg8::cvt_pk_bf16(v1[0], v1[1]); w.w = pg8::cvt_pk_bf16(v1[2], v1[3]);
                        *(v4u*)(yp + bj * 128) = w;
                    }
                }
                asm volatile("" ::: "memory");
            }
    }
};
__device__ __forceinline__ const LAS int* moe_counts_to_lds(Frame& F, const Args& a) {
    LAS int* c = (LAS int*)(F.lds + LDSX_OFF + 4096);
    if (F.tid < 64) c[F.tid] = (int)__hip_atomic_load((unsigned*)(a.ws + WS_CTL) + CW_CNT + F.tid, __ATOMIC_RELAXED, __HIP_MEMORY_SCOPE_AGENT);
    __syncthreads();
    return c;
}
__device__ __forceinline__ void phase6a(Frame& F, const Args& a) {
    const LAS int* c = moe_counts_to_lds(F, a);
    pg8::Gemm g{(const bf16*)(a.ws + WS_U2), (const bf16*)a.out, 1024, 64, 1024, (const int*)(a.ws + WS_LIST)};
    MoeOrder S{c, F.G, F.bid, 2, (size_t)512 * 1024 * 2, (size_t)256 * 1024 * 2};
    EpiMoe1 E{(bf16*)(a.ws + WS_HDN), (const int*)(a.ws + WS_LIST), (const float*)(a.ws + WS_RSTD2)};
    pg8::gemm_phase<EpiMoe1, MoeOrder, true>(F.lds, g, S, E);
}
struct MoeOrder2 : MoeOrder {
    __device__ bool next(int i, Unit& u) const { if (!MoeOrder::next(i, u)) return false; u.aoff = (size_t)u.pm * 256 * 256 * 2; return true; }
};
__device__ __forceinline__ void phase6b(Frame& F, const Args& a) {
    const LAS int* c = moe_counts_to_lds(F, a);
    pg8::Gemm g{(const bf16*)(a.ws + WS_HDN), (const bf16*)(a.ws + WS_W2T), 256, 64, 256, nullptr};
    MoeOrder2 S; S.cnt = c; S.G = F.G; S.bid = F.bid; S.NC = 4; S.bstride = (size_t)1024 * 256 * 2; S.bcol = (size_t)256 * 256 * 2;
    EpiMoe2 E{(bf16*)(a.ws + WS_Y), (const int*)(a.ws + WS_LIST), (const float*)(a.ws + WS_GATE)};
    pg8::gemm_phase<EpiMoe2, MoeOrder2>(F.lds, g, S, E);
}
__device__ __forceinline__ void phase7(Frame& F, const Args& a) {
    const float* H1 = (const float*)(a.ws + WS_H1); const bf16* Y = (const bf16*)(a.ws + WS_Y); const float* g = a.in[22];
    const int gw = F.bid * NWAVES + F.wave, NGW = F.G * NWAVES;
    f32x4 gv[4];
#pragma unroll
    for (int j = 0; j < 4; ++j) gv[j] = ((const f32x4*)g)[F.lane + 64 * j];
    for (int m = gw; m < MR; m += NGW) {
        const f32x4* hr = (const f32x4*)(H1 + (size_t)m * 1024) + F.lane;
        const v2u* y0 = (const v2u*)(Y + (size_t)m * 2048) + F.lane; const v2u* y1 = y0 + 256;
        f32x4 v[4]; float s = 0.f;
#pragma unroll
        for (int j = 0; j < 4; ++j) { const f32x4 hv = hr[64 * j]; const v2u p = y0[64 * j], q = y1[64 * j];
            v[j][0] = hv[0] + bflo(p.x) + bflo(q.x); v[j][1] = hv[1] + bfhi(p.x) + bfhi(q.x); v[j][2] = hv[2] + bflo(p.y) + bflo(q.y); v[j][3] = hv[3] + bfhi(p.y) + bfhi(q.y);
            s += (v[j][0] * v[j][0] + v[j][1] * v[j][1]) + (v[j][2] * v[j][2] + v[j][3] * v[j][3]); }
        const float rs = rsqrtf(wave_sum_x(s) * (1.0f / 1024.0f) + 1e-6f);
        f32x4* o = (f32x4*)(a.out + (size_t)m * 1024) + F.lane;
#pragma unroll
        for (int j = 0; j < 4; ++j) o[64 * j] = v[j] * rs * gv[j];
    }
}

__global__ void __launch_bounds__(NTHR, 2) mk_fwd(Args args) {
    extern __shared__ __attribute__((aligned(16))) unsigned char lds_raw[];
    cg::grid_group grid = cg::this_grid();
    Frame F;
    F.lds = (LAS unsigned char*)lds_raw;
    F.tid = threadIdx.x; F.lane = F.tid & 63; F.wave = __builtin_amdgcn_readfirstlane(F.tid >> 6);
    F.G = gridDim.x; F.bid = blockIdx.x; F.ws = args.ws;
    volatile LAS unsigned* MISC = (volatile LAS unsigned*)(F.lds + MISC_OFF);
    if (F.tid < 64) MISC[F.tid] = 0u;
    __syncthreads();
    XcdBarrier bar = xcd_barrier_post((unsigned*)(args.ws + WS_CTL) + CW_BAR, MISC + 8);
    if (args.never) grid.sync();
    const int lo = args.ph_lo, hi = args.ph_hi;
#define IN(k) (lo <= (k) && (k) < hi)
#define SEAM(k) do { if (IN(k) && IN((k) + 1)) xcd_barrier(bar); } while (0)
    if (IN(0)) { phase0(F, args); } SEAM(0);
    if (IN(1)) { phase1(F, args); } SEAM(1);
    if (IN(2)) { phase2_mla(F, args); phase2_hgrn(F, args); } SEAM(2);
    if (IN(3)) { phase3_scan(F, args); phase3_attn(F, args); } SEAM(3);
    if (IN(4)) { phase4_hgrn(F, args); } SEAM(4);
    if (IN(5)) { phase5a(F, args); } SEAM(5);
    if (IN(6)) { phase5b(F, args); } SEAM(6);
    if (IN(7)) { phase5c(F, args); } SEAM(7);
    if (IN(8)) { phase6a(F, args); } SEAM(8);
    if (IN(9)) { phase6b(F, args); } SEAM(9);
    if (IN(10)) { phase7(F, args); }
#undef IN
#undef SEAM
}
#ifndef N_LAUNCH_SPLIT
#define N_LAUNCH_SPLIT 0
#endif
extern "C" void kernel_launch(void* const* d_in, const int* in_sizes, int n_in, void* d_out, int out_size, void* d_ws, size_t ws_size, hipStream_t stream) {
    static int grid_blocks = 0;
    if (grid_blocks == 0) {
        if (n_in != 23 || out_size != MR * 1024 || ws_size < WS_END) { fprintf(stderr, "kernel_launch: unexpected problem (n_in %d out %d ws %zu); nothing launched\n", n_in, out_size, ws_size); grid_blocks = -1; return; }
        int dev = 0, cus = 0, per_cu = 0;
        hipGetDevice(&dev);
        hipDeviceGetAttribute(&cus, hipDeviceAttributeMultiprocessorCount, dev);
        hipFuncSetAttribute((const void*)mk_fwd, hipFuncAttributeMaxDynamicSharedMemorySize, LDS_BYTES);
        hipOccupancyMaxActiveBlocksPerMultiprocessor(&per_cu, mk_fwd, NTHR, LDS_BYTES);
        if (per_cu < 1 || cus != 256) { fprintf(stderr, "kernel_launch: needs 256 CUs with one resident 512-thread block each (cus %d, per_cu %d); nothing launched\n", cus, per_cu); grid_blocks = -1; return; }
        grid_blocks = cus;
    }
    if (grid_blocks < 0) return;
    hipMemsetAsync((char*)d_ws + WS_CTL, 0, CTL_ZERO_BYTES, stream);
    Args a{};
    for (int i = 0; i < 23; ++i) a.in[i] = (const float*)d_in[i];
    a.out = (float*)d_out; a.ws = (unsigned char*)d_ws; a.never = 0; a.pad = 0;
#if N_LAUNCH_SPLIT
    for (int p = 0; p < 11; ++p) {
        a.ph_lo = p; a.ph_hi = p + 1;
        void* args[] = {&a};
        hipError_t e = hipLaunchCooperativeKernel((const void*)mk_fwd, dim3(grid_blocks), dim3(NTHR), args, LDS_BYTES, stream);
        if (e != hipSuccess) fprintf(stderr, "cooperative launch failed: %s\n", hipGetErrorString(e));
    }
#else
    a.ph_lo = 0; a.ph_hi = 11;
    void* args[] = {&a};
    hipError_t e = hipLaunchCooperativeKernel((const void*)mk_fwd, dim3(grid_blocks), dim3(NTHR), args, LDS_BYTES, stream);
    if (e != hipSuccess) fprintf(stderr, "cooperative launch failed: %s (grid %d)\n", hipGetErrorString(e), grid_blocks);
#endif
}
```
